# Optimizing an MI355X kernel written in HIP

```python
import math
import jax, jax.numpy as jnp
from jax import lax
import numpy as np

D_MODEL = 1024
BATCH = 8
SEQ = 4096
DEPTH = 4

N_EVEN = (DEPTH + 1) // 2
N_ODD = DEPTH // 2

ATTN_HEADS = 4
QK_DIM = 64
V_DIM = 2 * QK_DIM
ATTN_WIDTH = ATTN_HEADS * V_DIM
Q_BLOCK = 128

LRU_WIDTH = D_MODEL // 2
LRU_HEADS = 4
LRU_HEAD_DIM = LRU_WIDTH // LRU_HEADS
CONV_WIDTH = 4
LRU_C = 8.0
LRU_MIN_RAD = 0.9
LRU_MAX_RAD = 0.999

Q_COLS = ATTN_HEADS * 2 * QK_DIM
K_COLS = ATTN_HEADS * 2 * QK_DIM
V_COLS = ATTN_WIDTH
IN_COLS = Q_COLS + K_COLS + V_COLS + 2 * LRU_WIDTH
MIX_WIDTH = ATTN_WIDTH + LRU_WIDTH

FOURIER_GROUPS = 4
FOURIER_GROUP_DIM = D_MODEL // FOURIER_GROUPS

D_FF = -(-8 * D_MODEL // (3 * 256)) * 256
EPS = 1e-6

kernel_name = 'hybrid_diffattn_rglru_fnet_encoder'


def rmsnorm(x, g):
    xf = x.astype(jnp.float32)
    y = xf * lax.rsqrt(jnp.mean(xf * xf, axis=-1, keepdims=True) + EPS) * g.astype(jnp.float32)
    return y.astype(x.dtype)


def alibi_slopes(n_heads):
    return jnp.exp2(-8.0 * jnp.arange(1, n_heads + 1, dtype=jnp.float32) / n_heads)


def diff_attention(q, k, v, lam, lam_init, subln_g):
    B, S = q.shape[0], q.shape[1]
    nb = S // Q_BLOCK
    scale = QK_DIM ** -0.5
    slopes = alibi_slopes(ATTN_HEADS)[None, :, None, None, None]
    kpos = jnp.arange(S)
    qb = q.reshape(B, nb, Q_BLOCK, ATTN_HEADS, 2, QK_DIM).transpose(1, 0, 2, 3, 4, 5)

    def block(args):
        qi, bi = args
        s = jnp.einsum('bqhmd,bkhmd->bhmqk', qi, k,
                       preferred_element_type=jnp.float32) * scale
        qpos = bi * Q_BLOCK + jnp.arange(Q_BLOCK)
        dist = jnp.abs(qpos[:, None] - kpos[None, :]).astype(jnp.float32)
        p = jax.nn.softmax(s - slopes * dist, axis=-1)
        a = p[:, :, 0] - lam * p[:, :, 1]
        return jnp.einsum('bhqk,bkhd->bqhd', a.astype(v.dtype), v)

    o = lax.map(block, (qb, jnp.arange(nb)))
    o = o.transpose(1, 0, 2, 3, 4).reshape(B, S, ATTN_HEADS, V_DIM)
    o = rmsnorm(o, subln_g) * (1.0 - lam_init)
    return o.reshape(B, S, ATTN_WIDTH)


def centred_depthwise_conv(x, w, b):
    C = x.shape[-1]
    pad_l = CONV_WIDTH // 2
    pad_r = CONV_WIDTH - 1 - pad_l
    y = lax.conv_general_dilated(x, w[:, None, :], window_strides=(1,),
                                 padding=[(pad_l, pad_r)],
                                 dimension_numbers=('NWC', 'WIO', 'NWC'),
                                 feature_group_count=C)
    return y + b


def _lin_combine(left, right):
    a1, b1 = left
    a2, b2 = right
    return a1 * a2, a2 * b1 + b2


def rg_lru(x, w_a, b_a, w_i, b_i, lam, reverse):
    B, S, C = x.shape
    xh = x.reshape(B, S, LRU_HEADS, LRU_HEAD_DIM)
    r = jax.nn.sigmoid(jnp.einsum('bshi,hij->bshj', xh, w_a).reshape(B, S, C) + b_a)
    i = jax.nn.sigmoid(jnp.einsum('bshi,hij->bshj', xh, w_i).reshape(B, S, C) + b_i)
    log_a = LRU_C * r.astype(jnp.float32) * jax.nn.log_sigmoid(lam.astype(jnp.float32))
    a = jnp.exp(log_a)
    u = jnp.sqrt(-jnp.expm1(2.0 * log_a)) * (i * x).astype(jnp.float32)
    _, h = lax.associative_scan(_lin_combine, (a, u), axis=1, reverse=reverse)
    return h.astype(x.dtype)


def hybrid_mixer(h, w_in, w_out, lq1, lk1, lq2, lk2, subln_g, conv_w, conv_b,
                 wa, ba, wi, bi, lru_lam, lam_init):
    B, S, _ = h.shape
    z = h @ w_in
    c1 = Q_COLS
    c2 = c1 + K_COLS
    c3 = c2 + V_COLS
    c4 = c3 + LRU_WIDTH
    q, k, v, xr, yg = jnp.split(z, [c1, c2, c3, c4], axis=-1)
    q = q.reshape(B, S, ATTN_HEADS, 2, QK_DIM)
    k = k.reshape(B, S, ATTN_HEADS, 2, QK_DIM)
    v = v.reshape(B, S, ATTN_HEADS, V_DIM)
    lam = (jnp.exp(jnp.sum(lq1.astype(jnp.float32) * lk1.astype(jnp.float32)))
           - jnp.exp(jnp.sum(lq2.astype(jnp.float32) * lk2.astype(jnp.float32)))
           + lam_init)
    attn = diff_attention(q, k, v, lam, lam_init, subln_g)
    xc = centred_depthwise_conv(xr, conv_w, conv_b)
    h_fwd = rg_lru(xc, wa[0], ba[0], wi[0], bi[0], lru_lam[0], False)
    h_bwd = rg_lru(xc, wa[1], ba[1], wi[1], bi[1], lru_lam[1], True)
    rec = (h_fwd + h_bwd) * jax.nn.gelu(yg, approximate=True)
    return jnp.concatenate([attn, rec], axis=-1) @ w_out


def fourier_mixer(h, w):
    B, S, D = h.shape
    g = h.astype(jnp.float32).reshape(B, S, FOURIER_GROUPS, FOURIER_GROUP_DIM)
    f = jnp.fft.fft2(g, axes=(1, 3), norm='ortho').real
    return f.reshape(B, S, D).astype(h.dtype) @ w


def swiglu(h, wg, wu, wd):
    return (jax.nn.silu(h @ wg) * (h @ wu)) @ wd


def setup_inputs(seed: int = 0) -> dict:
    key = jax.random.key(seed)
    ks = jax.random.split(key, 24)
    f32 = jnp.float32
    D = D_MODEL
    nrm = lambda k, shape, s: jax.random.normal(k, shape, f32) * s
    gain = lambda k, shape: 1.0 + 0.05 * jax.random.normal(k, shape, f32)
    rad2 = jax.random.uniform(ks[20], (N_EVEN, 2, LRU_WIDTH), f32,
                              LRU_MIN_RAD ** 2, LRU_MAX_RAD ** 2)
    a0 = jnp.sqrt(rad2)
    return {
        'x': jax.random.normal(ks[0], (BATCH, SEQ, D), f32),
        'ln_mix_pre': gain(ks[1], (DEPTH, D)),
        'ln_mix_post': gain(ks[2], (DEPTH, D)),
        'ln_ffn_pre': gain(ks[3], (DEPTH, D)),
        'ln_ffn_post': gain(ks[4], (DEPTH, D)),
        'w_in': nrm(ks[5], (N_EVEN, D, IN_COLS), D ** -0.5),
        'w_mix_out': nrm(ks[6], (N_EVEN, MIX_WIDTH, D), MIX_WIDTH ** -0.5),
        'lambda_q1': nrm(ks[7], (N_EVEN, QK_DIM), 0.1),
        'lambda_k1': nrm(ks[8], (N_EVEN, QK_DIM), 0.1),
        'lambda_q2': nrm(ks[9], (N_EVEN, QK_DIM), 0.1),
        'lambda_k2': nrm(ks[10], (N_EVEN, QK_DIM), 0.1),
        'attn_subln': gain(ks[11], (N_EVEN, V_DIM)),
        'conv_w': nrm(ks[12], (N_EVEN, CONV_WIDTH, LRU_WIDTH), CONV_WIDTH ** -0.5),
        'conv_b': nrm(ks[13], (N_EVEN, LRU_WIDTH), 0.01),
        'lru_w_a': nrm(ks[14], (N_EVEN, 2, LRU_HEADS, LRU_HEAD_DIM, LRU_HEAD_DIM), LRU_HEAD_DIM ** -0.5),
        'lru_b_a': nrm(ks[15], (N_EVEN, 2, LRU_WIDTH), 0.01),
        'lru_w_i': nrm(ks[16], (N_EVEN, 2, LRU_HEADS, LRU_HEAD_DIM, LRU_HEAD_DIM), LRU_HEAD_DIM ** -0.5),
        'lru_b_i': nrm(ks[17], (N_EVEN, 2, LRU_WIDTH), 0.01),
        'lru_lambda': jnp.log(a0) - jnp.log1p(-a0),
        'w_fourier_out': nrm(ks[18], (N_ODD, D, D), D ** -0.5),
        'w_ffn_gate': nrm(ks[19], (DEPTH, D, D_FF), D ** -0.5),
        'w_ffn_up': nrm(ks[21], (DEPTH, D, D_FF), D ** -0.5),
        'w_ffn_down': nrm(ks[22], (DEPTH, D_FF, D), D_FF ** -0.5),
    }


def reference(x, ln_mix_pre, ln_mix_post, ln_ffn_pre, ln_ffn_post, w_in, w_mix_out,
              lambda_q1, lambda_k1, lambda_q2, lambda_k2, attn_subln, conv_w, conv_b,
              lru_w_a, lru_b_a, lru_w_i, lru_b_i, lru_lambda, w_fourier_out,
              w_ffn_gate, w_ffn_up, w_ffn_down):
    for l in range(DEPTH):
        hn = rmsnorm(x, ln_mix_pre[l])
        if l % 2 == 0:
            e = l // 2
            lam_init = 0.8 - 0.6 * math.exp(-0.3 * l)
            m = hybrid_mixer(hn, w_in[e], w_mix_out[e], lambda_q1[e], lambda_k1[e],
                             lambda_q2[e], lambda_k2[e], attn_subln[e], conv_w[e], conv_b[e],
                             lru_w_a[e], lru_b_a[e], lru_w_i[e], lru_b_i[e], lru_lambda[e],
                             lam_init)
        else:
            m = fourier_mixer(hn, w_fourier_out[l // 2])
        x = x + rmsnorm(m, ln_mix_post[l])
        hn = rmsnorm(x, ln_ffn_pre[l])
        x = x + rmsnorm(swiglu(hn, w_ffn_gate[l], w_ffn_up[l], w_ffn_down[l]), ln_ffn_post[l])
    return x
```

```cpp
#include <hip/hip_runtime.h>
#include <hip/hip_cooperative_groups.h>
#include <cstdio>
namespace cg = cooperative_groups;

#ifndef MULTI_LAUNCH
#define MULTI_LAUNCH 0
#endif
#define PROBE_DUP 0

#define LAS __attribute__((address_space(3)))
#define DI __device__ __forceinline__
typedef unsigned short bf16_t;
typedef short bf16x8 __attribute__((ext_vector_type(8)));
typedef float f32x4 __attribute__((ext_vector_type(4)));
typedef float f32x2 __attribute__((ext_vector_type(2)));
typedef unsigned u32x4 __attribute__((ext_vector_type(4)));
typedef unsigned u32x2 __attribute__((ext_vector_type(2)));

constexpr int T_ = 32768, D_ = 1024, S_ = 4096, FF_ = 2816, INC_ = 2560;
constexpr float EPS_ = 1e-6f;
constexpr float LOG2E = 1.4426950408889634f;

constexpr size_t MiB = 1024 * 1024;
constexpr size_t WS_WIN = 0;
constexpr size_t WS_WOUT = WS_WIN + 10 * MiB;
constexpr size_t WS_WF = WS_WOUT + 4 * MiB;
constexpr size_t WS_WGU = WS_WF + 4 * MiB;
constexpr size_t WS_WD = WS_WGU + 44 * MiB;
constexpr size_t WS_WLRU = WS_WD + 22 * MiB;
constexpr size_t WS_WDFT = WS_WLRU + 2 * MiB;
constexpr size_t WS_MISC = WS_WDFT + MiB / 4;
constexpr size_t WS_A = WS_MISC + 4 * MiB;
constexpr size_t WS_B = WS_A + 64 * MiB;
constexpr size_t WS_GY = WS_B + 128 * MiB;
constexpr size_t WS_E = WS_GY + 32 * MiB;
constexpr size_t WS_CS = WS_E + 176 * MiB;
constexpr size_t WS_END = WS_CS + 16 * MiB;
constexpr size_t MI_NLS = 0;
constexpr size_t MI_LAM = 8192;
constexpr size_t MI_KMAX = 8192 + 64;
constexpr size_t MI_AGG = 16384;
constexpr size_t MI_BAR = 16384 + 2 * 1024 * 1024;
constexpr size_t BAR_BYTES = 3456 * 4;
constexpr size_t MI_Y2048 = MI_BAR + 16384;
constexpr size_t MI_ALT = MI_Y2048 + 32768;
constexpr size_t MI_H2048 = MI_ALT + 65536;

constexpr int ATT_RING = 3 * 45056;
constexpr int LDS_BARW = ATT_RING;
constexpr int LDS_MBW = ATT_RING + 64;
constexpr int LDS_TOTAL = ATT_RING + 128;
struct Params { const float* in[23]; float* out; unsigned char* ws; int ph_lo, ph_hi; unsigned char tab[80]; };

DI unsigned cvt_pk_bf16(float lo, float hi) { unsigned r; asm("v_cvt_pk_bf16_f32 %0, %1, %2" : "=v"(r) : "v"(lo), "v"(hi)); return r; }
DI unsigned cvt_pk_nv(float lo, float hi) { unsigned r; asm("v_cvt_pk_bf16_f32 %0, %1, %2" : "=v"(r) : "v"(lo), "v"(hi)); return r; }
DI int lane_id_asm() { int l; asm volatile("v_mbcnt_lo_u32_b32 %0, -1, 0\n\tv_mbcnt_hi_u32_b32 %0, -1, %0" : "=v"(l)); return l; }
DI float bf2f(unsigned short b) { return __uint_as_float(((unsigned)b) << 16); }
DI float bflo(unsigned w) { return __uint_as_float(w << 16); }
DI float bfhi(unsigned w) { return __uint_as_float(w & 0xffff0000u); }
DI float sigmoidf_(float x) { return __builtin_amdgcn_rcpf(1.0f + __builtin_amdgcn_exp2f(-LOG2E * x)); }
DI float gelu_tanh(float y) { const float u = 1.5957691216057308f * (y + 0.044715f * y * y * y); return y * sigmoidf_(u); }
#define dpp_f(v, ctrl) __builtin_bit_cast(float, __builtin_amdgcn_update_dpp(0, __builtin_bit_cast(int, (v)), (ctrl), 0xf, 0xf, false))
DI float wave_sum(float v) {
    v += dpp_f(v, 0xB1); v += dpp_f(v, 0x4E); v += dpp_f(v, 0x141); v += dpp_f(v, 0x140);
    v += __shfl_xor(v, 16); v += __shfl_xor(v, 32); return v; }

namespace pg8 {
constexpr int BM = 256, BK = 64, HALF = 128, HTB = HALF * BK * 2, STAGE_BYTES = 8 * HTB, NXCD = 8, WGM = 16;
DI int lds_byte(int r, int c) { const int st = (r >> 4) * 2 + (c >> 5), rr = r & 15, cc = c & 31, ob = rr * 64 + cc * 2; return st * 1024 + (ob ^ (((ob >> 9) & 1) << 5)); }
DI void stage_rc(int b, int& R, int& C) { const int st = b / 1024, sb = b % 1024, swz = sb ^ (((sb >> 9) & 1) << 5); R = (st >> 1) * 16 + swz / 64; C = (st & 1) * 32 + (swz % 64) / 2; }
DI int perm32(int rho) { const int n = rho >> 4, i = rho & 15; return 8 * (i >> 2) + 4 * n + (i & 3); }

struct Unit { int pm, pn, z; };
struct Gemm { const bf16_t* A; const bf16_t* Bt; int lda, ldb, K, nM, nN, nZ; long sAz, sBz; int zdiv = 1 << 30; long sAhi = 0, sBhi = 0; const bf16_t* A2 = nullptr; int swapN = 1 << 30; };

struct Sched {
    int nM, nN, nwg, total, G, c;
    DI void init(int nM_, int nN_, int nZ_, int G_, int c_) { nM = nM_; nN = nN_; nwg = nM * nN; total = nwg * nZ_; G = G_; c = c_; }
    DI bool next(int i, Unit& u) const {
        const long L = (long)i * G + c; if (L >= total) return false;
        const int z = (int)(L / nwg); int wgid = (int)(L - (long)z * nwg);
        { const int q = nwg / NXCD, r = nwg % NXCD, xcd = wgid % NXCD, off = wgid / NXCD; wgid = (xcd < r ? xcd * (q + 1) : r * (q + 1) + (xcd - r) * q) + off; }
        const int nig = WGM * nN, gid = wgid / nig, fm = gid * WGM, gsz = (nM - fm) < WGM ? (nM - fm) : WGM;
        u.pm = fm + ((wgid % nig) % gsz); u.pn = (wgid % nig) / gsz; u.z = z; return true;
    }
};

template <class Epi>
DI void gemm_phase(LAS unsigned char* lds, const Gemm g, const Epi& E, const int tid) {
    const int wid = __builtin_amdgcn_readfirstlane(tid >> 6), lane = tid & 63, wr = wid >> 2, wc = wid & 3, fr = lane & 15, fq = lane >> 4;
    const int K = g.K, nt = K / BK;
    int bid_ = (int)blockIdx.x; asm volatile("" : "+s"(bid_));
    Sched S; S.init(g.nM, g.nN, g.nZ, (int)gridDim.x, bid_);
    unsigned voffA[2], voffB[2];
#pragma unroll
    for (int i = 0; i < 2; ++i) { int R, C; stage_rc(tid * 16 + i * 8192, R, C); const int Rb = Epi::PERM ? ((R & ~31) + perm32(R & 31)) : R;
        voffA[i] = (unsigned)(R * g.lda + C) * 2u; voffB[i] = (unsigned)(Rb * g.ldb + C) * 2u; }
    const size_t kstep = (size_t)(BK * 2);
    const size_t hstepA = (size_t)HALF * g.lda * 2, hstepB = (size_t)HALF * g.ldb * 2;
    const unsigned ldsw = (unsigned)wid * 1024u;
    const int aoff = lds_byte(wr * 64 + fr, fq * 8), boff = lds_byte(wc * 32 + fr, fq * 8);
#define PG8_APTR(u) ((u).pn >= g.swapN ? (const char*)(g.A2 + (size_t)((u).pn - g.swapN) * 256 * g.lda) : (const char*)(g.A + (size_t)((u).z % g.zdiv) * g.sAz + (size_t)((u).z / g.zdiv) * g.sAhi + (size_t)(u).pm * 256 * g.lda))
#define PG8_BPTR(u) ((u).pn >= g.swapN ? (const char*)(g.A + (size_t)(u).pm * 256 * g.lda) : (const char*)(g.Bt + (size_t)((u).z % g.zdiv) * g.sBz + (size_t)((u).z / g.zdiv) * g.sBhi + (size_t)(u).pn * 256 * g.ldb))
#define PG8_SA(b, h) (((b) * 2 + (h)) * HTB)
#define PG8_SB(b, h) ((4 + (b) * 2 + (h)) * HTB)
#define PG8_STAGE(bufoff, gbase, voff) do { _Pragma("unroll") for (int _i = 0; _i < 2; ++_i) \
        __builtin_amdgcn_global_load_lds((const unsigned*)((const char*)(gbase) + (voff)[_i]), (LAS unsigned*)(lds + (bufoff) + ldsw + _i * 8192), 16, 0, 0); } while (0)
#define PG8_LDA(dst, b, h) do { _Pragma("unroll") for (int m = 0; m < 4; ++m) _Pragma("unroll") for (int k = 0; k < 2; ++k) dst[m][k] = *(const LAS bf16x8*)(lds + PG8_SA(b, h) + aoff + m * 2048 + k * 1024); } while (0)
#define PG8_LDB(dst, b, h) do { _Pragma("unroll") for (int n = 0; n < 2; ++n) _Pragma("unroll") for (int k = 0; k < 2; ++k) dst[n][k] = *(const LAS bf16x8*)(lds + PG8_SB(b, h) + boff + n * 2048 + k * 1024); } while (0)
#define PG8_MMA(ai, bj, At, Bt) do { __builtin_amdgcn_s_setprio(1); _Pragma("unroll") for (int m = 0; m < 4; ++m) _Pragma("unroll") for (int n = 0; n < 2; ++n) _Pragma("unroll") for (int k = 0; k < 2; ++k) \
        acc[ai][bj][m][n] = __builtin_amdgcn_mfma_f32_16x16x32_bf16(Bt[n][k], At[m][k], acc[ai][bj][m][n], 0, 0, 0); __builtin_amdgcn_s_setprio(0); } while (0)
#define PG8_WAIT_V(n) asm volatile("s_waitcnt vmcnt(" #n ")" ::: "memory")
#define PG8_WAIT_L(n) asm volatile("s_waitcnt lgkmcnt(" #n ")" ::: "memory")
#define PG8_BAR __builtin_amdgcn_s_barrier()
#define PG8_SCHED __builtin_amdgcn_sched_barrier(0)
    Unit cur, nxt; int ui = 0;
    if (!S.next(0, cur)) return;
    f32x4 acc[2][2][4][2];
#pragma unroll
    for (int a = 0; a < 2; ++a)
#pragma unroll
        for (int b = 0; b < 2; ++b)
#pragma unroll
            for (int m = 0; m < 4; ++m)
#pragma unroll
                for (int n = 0; n < 2; ++n) acc[a][b][m][n] = (f32x4){0.f, 0.f, 0.f, 0.f};
    bf16x8 At[4][2], B0[2][2], B1[2][2];
    const char* cA = PG8_APTR(cur); const char* cB = PG8_BPTR(cur);
    PG8_STAGE(PG8_SB(0, 0), cB, voffB); PG8_STAGE(PG8_SA(0, 0), cA, voffA); PG8_STAGE(PG8_SB(0, 1), cB + hstepB, voffB); PG8_STAGE(PG8_SA(0, 1), cA + hstepA, voffA);
    if (wr == 1) PG8_BAR;
    PG8_WAIT_V(4); PG8_BAR;
    PG8_STAGE(PG8_SB(1, 0), cB + kstep, voffB); PG8_STAGE(PG8_SA(1, 0), cA + kstep, voffA); PG8_STAGE(PG8_SB(1, 1), cB + hstepB + kstep, voffB);
    PG8_WAIT_V(6); PG8_BAR;
    for (;;) {
        const bool has_next = S.next(ui + 1, nxt);
        const char* nA = has_next ? PG8_APTR(nxt) : cA; const char* nB = has_next ? PG8_BPTR(nxt) : cB;
        for (int t = 0; t < nt; t += 2) {
            const bool last = (t == nt - 2);
            const char* a1 = cA + (size_t)(t + 1) * kstep;
            const char* a2 = last ? nA : cA + (size_t)(t + 2) * kstep; const char* b2 = last ? nB : cB + (size_t)(t + 2) * kstep;
            const char* a3 = a2 + kstep; const char* b3 = b2 + kstep;
            PG8_LDB(B0, 0, 0); PG8_SCHED; PG8_LDA(At, 0, 0); PG8_STAGE(PG8_SA(1, 1), a1 + hstepA, voffA);
            PG8_WAIT_L(8); PG8_BAR; PG8_WAIT_L(0); PG8_MMA(0, 0, At, B0); PG8_BAR; PG8_SCHED;
            PG8_LDB(B1, 0, 1); PG8_STAGE(PG8_SB(0, 0), b2, voffB);
            PG8_BAR; PG8_WAIT_L(0); PG8_MMA(0, 1, At, B1); PG8_BAR;
            PG8_LDA(At, 0, 1); PG8_STAGE(PG8_SA(0, 0), a2, voffA);
            PG8_BAR; PG8_WAIT_L(0); PG8_MMA(1, 0, At, B0); PG8_BAR; PG8_SCHED;
            PG8_STAGE(PG8_SB(0, 1), b2 + hstepB, voffB);
            PG8_WAIT_V(6); PG8_BAR; PG8_MMA(1, 1, At, B1); PG8_BAR;
            PG8_LDB(B0, 1, 0); PG8_SCHED; PG8_LDA(At, 1, 0); PG8_STAGE(PG8_SA(0, 1), a2 + hstepA, voffA);
            PG8_WAIT_L(8); PG8_BAR; PG8_WAIT_L(0); PG8_MMA(0, 0, At, B0); PG8_BAR; PG8_SCHED;
            PG8_LDB(B1, 1, 1); PG8_STAGE(PG8_SB(1, 0), b3, voffB);
            PG8_BAR; PG8_WAIT_L(0); PG8_MMA(0, 1, At, B1); PG8_BAR;
            PG8_LDA(At, 1, 1); PG8_STAGE(PG8_SA(1, 0), a3, voffA);
            PG8_BAR; PG8_WAIT_L(0); PG8_MMA(1, 0, At, B0); PG8_BAR; PG8_SCHED;
            PG8_STAGE(PG8_SB(1, 1), b3 + hstepB, voffB);
            PG8_WAIT_V(6); PG8_BAR; PG8_MMA(1, 1, At, B1); PG8_BAR;
        }
        { const int lane_e = lane_id_asm();
          E(acc, cur, wr, wc, lane_e & 15, lane_e >> 4); }
        if (!has_next) break;
#pragma unroll
        for (int a = 0; a < 2; ++a)
#pragma unroll
            for (int b = 0; b < 2; ++b)
#pragma unroll
                for (int m = 0; m < 4; ++m)
#pragma unroll
                    for (int n = 0; n < 2; ++n) acc[a][b][m][n] = (f32x4){0.f, 0.f, 0.f, 0.f};
        cur = nxt; cA = nA; cB = nB; ++ui;
    }
    PG8_WAIT_V(0);
    if (wr == 0) PG8_BAR;
    PG8_BAR;
#undef PG8_APTR
#undef PG8_BPTR
#undef PG8_SA
#undef PG8_SB
#undef PG8_STAGE
#undef PG8_LDA
#undef PG8_LDB
#undef PG8_MMA
#undef PG8_WAIT_V
#undef PG8_WAIT_L
#undef PG8_BAR
#undef PG8_SCHED
}

struct EpiPlain {
    static constexpr bool PERM = true;
    bf16_t* O; int ldc; int zrows;
    DI void operator()(const f32x4 (&acc)[2][2][4][2], const Unit& u, int wr, int wc, int fr, int fq) const {
        const int row0 = u.z * zrows + u.pm * BM + wr * 64 + fr, col0 = u.pn * BM + wc * 32 + 8 * fq;
#pragma unroll
        for (int ai = 0; ai < 2; ++ai)
#pragma unroll
            for (int m = 0; m < 4; ++m) { bf16_t* rowp = O + (size_t)(row0 + ai * HALF + m * 16) * ldc + col0;
#pragma unroll
                for (int bj = 0; bj < 2; ++bj) { const f32x4 v0 = acc[ai][bj][m][0], v1 = acc[ai][bj][m][1];
                    u32x4 w; w.x = cvt_pk_bf16(v0[0], v0[1]); w.y = cvt_pk_bf16(v0[2], v0[3]); w.z = cvt_pk_bf16(v1[0], v1[1]); w.w = cvt_pk_bf16(v1[2], v1[3]);
                    *(u32x4*)(rowp + bj * HALF) = w; } }
    }
};
struct EpiSwiglu {
    static constexpr bool PERM = true;
    bf16_t* O;
    DI void operator()(const f32x4 (&acc)[2][2][4][2], const Unit& u, int wr, int wc, int fr, int fq) const {
        const int row0 = u.pm * BM + wr * 64 + fr, col0 = u.pn * HALF + wc * 32 + 8 * fq;
#pragma unroll
        for (int ai = 0; ai < 2; ++ai)
#pragma unroll
            for (int m = 0; m < 4; ++m) { bf16_t* rowp = O + (size_t)(row0 + ai * HALF + m * 16) * FF_ + col0;
                float ex[8], r[8];
#pragma unroll
                for (int i = 0; i < 8; ++i) ex[i] = __builtin_amdgcn_exp2f(-LOG2E * acc[ai][0][m][i >> 2][i & 3]);
#pragma unroll
                for (int i = 0; i < 8; ++i) ex[i] = __builtin_amdgcn_rcpf(1.0f + ex[i]);
#pragma unroll
                for (int i = 0; i < 8; ++i) r[i] = acc[ai][0][m][i >> 2][i & 3] * ex[i] * acc[ai][1][m][i >> 2][i & 3];
                u32x4 w; w.x = cvt_pk_nv(r[0], r[1]); w.y = cvt_pk_nv(r[2], r[3]); w.z = cvt_pk_nv(r[4], r[5]); w.w = cvt_pk_nv(r[6], r[7]);
                *(u32x4*)rowp = w; }
    }
};
struct EpiG1 {
    static constexpr bool PERM = true;
    bf16_t *q, *k, *vt, *xr, *gy;
    DI void operator()(const f32x4 (&acc)[2][2][4][2], const Unit& u, int wr, int wc, int fr, int fq) const {
        const int row0 = u.pm * BM + wr * 64 + fr;
        if (u.pn >= 8) {
            const int r0 = (u.pn - 8) * BM + wr * 64 + fr, t0 = u.pm * BM + wc * 32 + 8 * fq;
#pragma unroll
            for (int ai = 0; ai < 2; ++ai)
#pragma unroll
                for (int m = 0; m < 4; ++m) { const int vrow = r0 + ai * HALF + m * 16;
#pragma unroll
                    for (int bj = 0; bj < 2; ++bj) { const int t = t0 + bj * HALF; const int b = t >> 12, sq = t & 4095;
                        const f32x4 v0 = acc[ai][bj][m][0], v1 = acc[ai][bj][m][1];
                        u32x4 w; w.x = cvt_pk_bf16(v0[0], v0[1]); w.y = cvt_pk_bf16(v0[2], v0[3]); w.z = cvt_pk_bf16(v1[0], v1[1]); w.w = cvt_pk_bf16(v1[2], v1[3]);
                        *(u32x4*)(vt + ((size_t)(b * 512 + vrow)) * S_ + sq) = w; } }
            return;
        }
        const int sec = u.pn >> 1;
        const int colb = (u.pn & 1) * BM + wc * 32 + 8 * fq;
        bf16_t* base = sec == 0 ? q : (sec == 1 ? k : (sec == 2 ? xr : gy));
        const float sc = sec == 0 ? (0.125f * LOG2E) : 1.0f;
#pragma unroll
        for (int ai = 0; ai < 2; ++ai)
#pragma unroll
            for (int m = 0; m < 4; ++m) { bf16_t* rowp = base + (size_t)(row0 + ai * HALF + m * 16) * 512 + colb;
#pragma unroll
                for (int bj = 0; bj < 2; ++bj) { f32x4 v0 = acc[ai][bj][m][0] * sc, v1 = acc[ai][bj][m][1] * sc;
                    if (sec == 3) {
                        float ge[8];
#pragma unroll
                        for (int j = 0; j < 8; ++j) { const float y = j < 4 ? v0[j & 3] : v1[j & 3]; ge[j] = __builtin_amdgcn_exp2f(-LOG2E * 1.5957691216057308f * (y + 0.044715f * y * y * y)); }
#pragma unroll
                        for (int j = 0; j < 8; ++j) ge[j] = __builtin_amdgcn_rcpf(1.0f + ge[j]);
#pragma unroll
                        for (int j = 0; j < 4; ++j) { v0[j] *= ge[j]; v1[j] *= ge[4 + j]; } }
                    u32x4 w; w.x = cvt_pk_bf16(v0[0], v0[1]); w.y = cvt_pk_bf16(v0[2], v0[3]); w.z = cvt_pk_bf16(v1[0], v1[1]); w.w = cvt_pk_bf16(v1[2], v1[3]);
                    *(u32x4*)(rowp + bj * HALF) = w; } }
    }
};
struct EpiGates {
    static constexpr bool PERM = false;
    const bf16_t* xc; const float* ba; const float* bi; const float* nls; unsigned* au;
    DI void operator()(const f32x4 (&acc)[2][2][4][2], const Unit& u, int wr, int wc, int fr, int fq) const {
        const int row0 = u.pm * BM + wr * 64 + fr, dir = u.pn;
#pragma unroll
        for (int n = 0; n < 2; ++n) {
            const int c = u.z * 128 + wc * 32 + 16 * n + 4 * fq;
            const f32x4 bav = *(const f32x4*)(ba + dir * 512 + c), biv = *(const f32x4*)(bi + dir * 512 + c), nl = *(const f32x4*)(nls + dir * 512 + c);
#pragma unroll
            for (int ai = 0; ai < 2; ++ai)
#pragma unroll
                for (int m = 0; m < 4; ++m) { const int row = row0 + ai * HALF + m * 16;
                    const u32x2 xw = *(const u32x2*)(xc + (size_t)row * 512 + c);
                    const float xv[4] = {bflo(xw.x), bfhi(xw.x), bflo(xw.y), bfhi(xw.y)};
                    u32x4 w; float e1[4], e2[4], la[4], sq[4];
#pragma unroll
                    for (int j = 0; j < 4; ++j) { e1[j] = __builtin_amdgcn_exp2f(-LOG2E * (acc[ai][0][m][n][j] + bav[j])); e2[j] = __builtin_amdgcn_exp2f(-LOG2E * (acc[ai][1][m][n][j] + biv[j])); }
#pragma unroll
                    for (int j = 0; j < 4; ++j) { e1[j] = __builtin_amdgcn_rcpf(1.0f + e1[j]); e2[j] = __builtin_amdgcn_rcpf(1.0f + e2[j]); }
#pragma unroll
                    for (int j = 0; j < 4; ++j) { la[j] = e1[j] * nl[j]; sq[j] = __builtin_amdgcn_exp2f(2.0f * la[j]); }
#pragma unroll
                    for (int j = 0; j < 4; ++j) sq[j] = __builtin_amdgcn_sqrtf(fmaxf(1.0f - sq[j], 0.f));
#pragma unroll
                    for (int j = 0; j < 4; ++j) w[j] = cvt_pk_nv(la[j], sq[j] * e2[j] * xv[j]);
                    *(u32x4*)(au + ((size_t)dir * T_ + row) * 512 + c) = w; }
        }
    }
};
struct EpiDftC {
    static constexpr bool PERM = true;
    bf16_t* Yt;
    DI void operator()(const f32x4 (&acc)[2][2][4][2], const Unit& u, int wr, int wc, int fr, int fq) const {
        const int nl0 = wr * 64 + fr, t0 = u.pn * BM + wc * 32 + 8 * fq;
#pragma unroll
        for (int ai = 0; ai < 2; ++ai)
#pragma unroll
            for (int m = 0; m < 4; ++m) { const int nl = nl0 + ai * HALF + m * 16;
#pragma unroll
                for (int bj = 0; bj < 2; ++bj) { const int t = t0 + bj * HALF; const int b = t >> 12, s = t & 4095;
                    const f32x4 v0 = acc[ai][bj][m][0], v1 = acc[ai][bj][m][1];
                    u32x4 w; w.x = cvt_pk_bf16(v0[0], v0[1]); w.y = cvt_pk_bf16(v0[2], v0[3]); w.z = cvt_pk_bf16(v1[0], v1[1]); w.w = cvt_pk_bf16(v1[2], v1[3]);
                    *(u32x4*)(Yt + (((size_t)(b * 1024 + u.z * 256 + nl)) * 2 + u.pm) * S_ + s) = w; } }
    }
};


struct EpiDftC2 {
    static constexpr bool PERM = true;
    bf16_t* Ye;
    DI void operator()(const f32x4 (&acc)[2][2][4][2], const Unit& u, int wr, int wc, int fr, int fq) const {
        const int nl0 = wr * 64 + fr, t0 = u.pn * BM + wc * 32 + 8 * fq, part = u.z >> 2, gq = u.z & 3;
#pragma unroll
        for (int ai = 0; ai < 2; ++ai)
#pragma unroll
            for (int m = 0; m < 4; ++m) { const int nl = nl0 + ai * HALF + m * 16;
#pragma unroll
                for (int bj = 0; bj < 2; ++bj) { const int t = t0 + bj * HALF; const int b = t >> 11, sq = t & 2047;
                    const f32x4 v0 = acc[ai][bj][m][0], v1 = acc[ai][bj][m][1];
                    u32x4 w; w.x = cvt_pk_bf16(v0[0], v0[1]); w.y = cvt_pk_bf16(v0[2], v0[3]); w.z = cvt_pk_bf16(v1[0], v1[1]); w.w = cvt_pk_bf16(v1[2], v1[3]);
                    *(u32x4*)(Ye + (((size_t)(b * 1024 + gq * 256 + nl)) * 2 + part) * 2048 + sq) = w; } }
    }
};

struct EpiF32 {
    static constexpr bool PERM = false;
    float* C; int ldc; int zrows;
    DI void operator()(const f32x4 (&acc)[2][2][4][2], const Unit& u, int wr, int wc, int fr, int fq) const {
        const int row0 = u.z * zrows + u.pm * BM + wr * 64 + fr, col0 = u.pn * BM + wc * 32 + 4 * fq;
#pragma unroll
        for (int ai = 0; ai < 2; ++ai)
#pragma unroll
            for (int m = 0; m < 4; ++m) { float* rowp = C + (size_t)(row0 + ai * HALF + m * 16) * ldc + col0;
#pragma unroll
                for (int bj = 0; bj < 2; ++bj)
#pragma unroll
                    for (int n = 0; n < 2; ++n) *(f32x4*)(rowp + bj * HALF + n * 16) = acc[ai][bj][m][n]; }
    }
};
struct EpiDftQ {
    static constexpr bool PERM = false;
    const float* Pm; const float* y2048; bf16_t* F;
    DI void operator()(const f32x4 (&acc)[2][2][4][2], const Unit& u, int wr, int wc, int fr, int fq) const {
        const int k0 = u.pm * BM + wr * 64 + fr, col0 = u.pn * BM + wc * 32 + 4 * fq, b = u.z;
#pragma unroll
        for (int bj = 0; bj < 2; ++bj)
#pragma unroll
            for (int n = 0; n < 2; ++n) { const int c = col0 + bj * HALF + n * 16;
                const f32x4 yv = *(const f32x4*)(y2048 + b * 1024 + c) * (1.0f / 64.0f);
#pragma unroll
                for (int ai = 0; ai < 2; ++ai)
#pragma unroll
                    for (int m = 0; m < 4; ++m) { const int k = k0 + ai * HALF + m * 16;
                        const f32x4 pv = __builtin_nontemporal_load((const f32x4*)(Pm + ((size_t)(b * 2048 + k)) * 1024 + c)) + ((k & 1) ? -yv : yv);
                        const f32x4 q = acc[ai][bj][m][n]; const f32x4 f1 = pv - q, f2 = pv + q;
                        u32x2 w1; w1.x = cvt_pk_bf16(f1[0], f1[1]); w1.y = cvt_pk_bf16(f1[2], f1[3]);
                        *(u32x2*)(F + ((size_t)(b * 4096 + k)) * 1024 + c) = w1;
                        if (k) { u32x2 w2; w2.x = cvt_pk_bf16(f2[0], f2[1]); w2.y = cvt_pk_bf16(f2[2], f2[3]); *(u32x2*)(F + ((size_t)(b * 4096 + 4096 - k)) * 1024 + c) = w2; }
                        asm volatile("" ::: "memory"); }
            }
    }
};

struct EpiDftPQ {
    static constexpr bool PERM = false;
    float* Pm; const float* y2048; bf16_t* F;
    DI void operator()(const f32x4 (&acc)[2][2][4][2], const Unit& u, int wr, int wc, int fr, int fq) const {
        if (u.z < 8) { const EpiF32 e{Pm, D_, 2048}; e(acc, u, wr, wc, fr, fq); }
        else { Unit v = u; v.z = u.z - 8; const EpiDftQ e{Pm, y2048, F}; e(acc, v, wr, wc, fr, fq); }
    }
};
}


#define XB_TMO      128
#define XB_XCNT(j)  (256  + 64 * (j))
#define XB_XSUB(j)  (1280 + 64 * (j))
#define XB_XGEN(j)  (2304 + 64 * (j))
#define XB_TOP      3328
#define XB_TOPGEN   3392
#define XCD_BAR_WORDS 3456
#define XB_SPIN_CAP (1u << 20)
DI unsigned xb_ld(unsigned* p)              { return __hip_atomic_load(p, __ATOMIC_RELAXED, __HIP_MEMORY_SCOPE_AGENT); }
DI unsigned xb_add(unsigned* p, unsigned v) { return __hip_atomic_fetch_add(p, v, __ATOMIC_RELAXED, __HIP_MEMORY_SCOPE_AGENT); }
DI unsigned xb_xcc_id() { return (unsigned)__builtin_amdgcn_s_getreg((3 << 11) | 20) & 0xFu; }
#define XB_SPIN(cond, bar) do { unsigned _sp = 0; while (cond) { __builtin_amdgcn_s_sleep(1); \
    if ((++_sp & 255u) == 0u) { if (xb_ld(&(bar)[XB_TMO])) break; if (_sp > XB_SPIN_CAP) { atomicAdd(&(bar)[XB_TMO], 1u); break; } } } } while (0)
DI void xcd_barrier_complete(unsigned* bar, unsigned x, unsigned& nloc, unsigned& nx) {
    const unsigned G = gridDim.x;
    unsigned sum, cnt, mine, sp = 0u;
    for (;;) {
        sum = 0u; cnt = 0u; mine = 0u;
#pragma unroll
        for (unsigned j = 0; j < 16; ++j) { const unsigned c = xb_ld(&bar[XB_XCNT(j)]); sum += c; cnt += (c > 0u) ? 1u : 0u; mine = (j == x) ? c : mine; }
        if (sum == G) break;
        __builtin_amdgcn_s_sleep(1);
        if ((++sp & 255u) == 0u) { if (xb_ld(&bar[XB_TMO])) break; if (sp > XB_SPIN_CAP) { atomicAdd(&bar[XB_TMO], 1u); break; } }
    }
    nloc = mine > 0u ? mine : 1u; nx = cnt > 0u ? cnt : 1u;
}
DI void xcd_barrier(unsigned* bar, volatile LAS unsigned* st, bool leader) {
    asm volatile("s_waitcnt vmcnt(0)" ::: "memory");
    __syncthreads();
    if (leader) {
        const unsigned x = xb_xcc_id();
        __builtin_amdgcn_s_waitcnt(0);
        unsigned nloc = st[0], nx = st[1];
        if (nloc == 0u) { xcd_barrier_complete(bar, x, nloc, nx); st[0] = nloc; st[1] = nx; }
        const unsigned old = xb_add(&bar[XB_XSUB(x)], 1u);
        const unsigned gen = old / nloc;
        if (old + 1u == (gen + 1u) * nloc) {
            __builtin_amdgcn_fence(__ATOMIC_RELEASE, "agent");
            asm volatile("s_waitcnt vmcnt(0)" ::: "memory");
            const unsigned og = xb_add(&bar[XB_TOP], 1u);
            const unsigned tg = og / nx;
            if (og + 1u == (tg + 1u) * nx) xb_add(&bar[XB_TOPGEN], 1u);
            else XB_SPIN(xb_ld(&bar[XB_TOPGEN]) == tg, bar);
            __builtin_amdgcn_fence(__ATOMIC_ACQUIRE, "agent");
            xb_add(&bar[XB_XGEN(x)], 1u);
            asm volatile("s_waitcnt vmcnt(0)" ::: "memory");
        } else {
            XB_SPIN(xb_ld(&bar[XB_XGEN(x)]) == gen, bar);
            __builtin_amdgcn_fence(__ATOMIC_ACQUIRE, "agent");
            asm volatile("s_waitcnt vmcnt(0)" ::: "memory");
        }
    }
    __syncthreads();
}

DI void transpose_cvt(const int tid, LAS float* tl, const float* src, int K, int N, bf16_t* dst, int ldd, int mode) {
    const int tk = K / 64, tn = N / 64;
    for (int tile = blockIdx.x; tile < tk * tn; tile += gridDim.x) {
        const int k0 = (tile / tn) * 64, n0 = (tile % tn) * 64;
        __syncthreads();
#pragma unroll
        for (int i = 0; i < 8; ++i) { const int kk = (tid >> 6) + 8 * i, nn = tid & 63; tl[kk * 65 + nn] = __builtin_nontemporal_load(src + (size_t)(k0 + kk) * N + n0 + nn); }
        __syncthreads();
        const int nl = tid >> 3, kc = tid & 7; float v[8];
#pragma unroll
        for (int j = 0; j < 8; ++j) v[j] = tl[(kc * 8 + j) * 65 + nl];
        const int n = n0 + nl; const int drow = mode == 0 ? n : (mode == 3 ? (n < 1024 ? n : (n < 1536 ? n + 1024 : n - 512)) : ((n >> 7) * 256 + (n & 127) + (mode == 2 ? 128 : 0)));
        u32x4 w; w.x = cvt_pk_bf16(v[0], v[1]); w.y = cvt_pk_bf16(v[2], v[3]); w.z = cvt_pk_bf16(v[4], v[5]); w.w = cvt_pk_bf16(v[6], v[7]);
        *(u32x4*)(dst + (size_t)drow * ldd + k0 + kc * 8) = w;
    }
}

DI void rowpass(const int tid, const float* xin, float* xout, const bf16_t* m, const float* gpost, const float* gnext, bf16_t* hn, const bf16_t* m2 = nullptr, const float* gpost2 = nullptr) {
    const int lane = tid & 63, wid = tid >> 6;
    const int stride = gridDim.x * 16;
    int row0 = (blockIdx.x * 8 + wid) * 2;
    f32x4 x[2][4]; u32x2 mw[2][4], mw2[2][4];
#define ROW_LOAD(X, M, M2, R0) do { _Pragma("unroll") for (int r = 0; r < 2; ++r) _Pragma("unroll") for (int i = 0; i < 4; ++i) { \
        X[r][i] = __builtin_nontemporal_load((const f32x4*)(xin + (size_t)((R0) + r) * D_ + i * 256 + lane * 4)); \
        if (m) M[r][i] = __builtin_nontemporal_load((const u32x2*)(m + (size_t)((R0) + r) * D_ + i * 256 + lane * 4)); \
        if (m2) M2[r][i] = __builtin_nontemporal_load((const u32x2*)(m2 + (size_t)((R0) + r) * D_ + i * 256 + lane * 4)); } } while (0)
    if (row0 < T_) ROW_LOAD(x, mw, mw2, row0);
    for (; row0 < T_; row0 += stride) {
        f32x4 xn[2][4]; u32x2 mn[2][4], mn2[2][4];
        const int nrow = row0 + stride;
        if (nrow < T_) ROW_LOAD(xn, mn, mn2, nrow);
        if (m) {
#pragma unroll
            for (int r = 0; r < 2; ++r) {
                f32x4 mv[4]; float ss = 0.f;
#pragma unroll
                for (int i = 0; i < 4; ++i) { const u32x2 w = mw[r][i];
                    mv[i] = (f32x4){bflo(w.x), bfhi(w.x), bflo(w.y), bfhi(w.y)}; ss += mv[i][0] * mv[i][0] + mv[i][1] * mv[i][1] + mv[i][2] * mv[i][2] + mv[i][3] * mv[i][3]; }
                ss = wave_sum(ss); const float rr = __builtin_amdgcn_rsqf(ss * (1.0f / D_) + EPS_);
#pragma unroll
                for (int i = 0; i < 4; ++i) { const f32x4 gp = *(const f32x4*)(gpost + i * 256 + lane * 4); x[r][i] += mv[i] * rr * gp; }
                if (m2) {
                    float s2 = 0.f;
#pragma unroll
                    for (int i = 0; i < 4; ++i) { const u32x2 w = mw2[r][i];
                        mv[i] = (f32x4){bflo(w.x), bfhi(w.x), bflo(w.y), bfhi(w.y)}; s2 += mv[i][0] * mv[i][0] + mv[i][1] * mv[i][1] + mv[i][2] * mv[i][2] + mv[i][3] * mv[i][3]; }
                    s2 = wave_sum(s2); const float r2 = __builtin_amdgcn_rsqf(s2 * (1.0f / D_) + EPS_);
#pragma unroll
                    for (int i = 0; i < 4; ++i) { const f32x4 gp = *(const f32x4*)(gpost2 + i * 256 + lane * 4); x[r][i] += mv[i] * r2 * gp; }
                }
                if (xout) {
#pragma unroll
                    for (int i = 0; i < 4; ++i) __builtin_nontemporal_store(x[r][i], (f32x4*)(xout + (size_t)(row0 + r) * D_ + i * 256 + lane * 4)); }
            }
        }
        if (hn) {
#pragma unroll
            for (int r = 0; r < 2; ++r) {
                float ss = 0.f;
#pragma unroll
                for (int i = 0; i < 4; ++i) ss += x[r][i][0] * x[r][i][0] + x[r][i][1] * x[r][i][1] + x[r][i][2] * x[r][i][2] + x[r][i][3] * x[r][i][3];
                ss = wave_sum(ss); const float rr = __builtin_amdgcn_rsqf(ss * (1.0f / D_) + EPS_);
#pragma unroll
                for (int i = 0; i < 4; ++i) { const f32x4 gn = *(const f32x4*)(gnext + i * 256 + lane * 4); const f32x4 y = x[r][i] * rr * gn;
                    u32x2 w; w.x = cvt_pk_bf16(y[0], y[1]); w.y = cvt_pk_bf16(y[2], y[3]); *(u32x2*)(hn + (size_t)(row0 + r) * D_ + i * 256 + lane * 4) = w; }
            }
        }
#pragma unroll
        for (int r = 0; r < 2; ++r)
#pragma unroll
            for (int i = 0; i < 4; ++i) { x[r][i] = xn[r][i]; mw[r][i] = mn[r][i]; mw2[r][i] = mn2[r][i]; }
    }
#undef ROW_LOAD
}

DI void rowpass_fold(const int tid, const float* xin, float* xout, const bf16_t* m, const float* gpost, const bf16_t* m2, const float* gpost2, const float* gnext, bf16_t* He, bf16_t* Ho, float* alt, float* h2048) {
    const int lane = tid & 63, wid = tid >> 6;
    const int nW = gridDim.x * 8;
    f32x4 x[2][4]; u32x2 mw[2][4], mw2[2][4];
#define FOLD_ROWS(IDX, B, SQ, RA, RB) const int B = ((IDX) & 2047) >> 8, SQ = ((IDX) & 255) + 256 * ((IDX) >> 11); const int RA = B * S_ + SQ, RB = B * S_ + (SQ ? S_ - SQ : 2048)
#define FOLD_LOAD(X, M, M2, RA, RB) do { _Pragma("unroll") for (int i = 0; i < 4; ++i) { \
        X[0][i] = __builtin_nontemporal_load((const f32x4*)(xin + (size_t)(RA) * D_ + i * 256 + lane * 4)); X[1][i] = __builtin_nontemporal_load((const f32x4*)(xin + (size_t)(RB) * D_ + i * 256 + lane * 4)); \
        M[0][i] = __builtin_nontemporal_load((const u32x2*)(m + (size_t)(RA) * D_ + i * 256 + lane * 4)); M[1][i] = __builtin_nontemporal_load((const u32x2*)(m + (size_t)(RB) * D_ + i * 256 + lane * 4)); \
        M2[0][i] = __builtin_nontemporal_load((const u32x2*)(m2 + (size_t)(RA) * D_ + i * 256 + lane * 4)); M2[1][i] = __builtin_nontemporal_load((const u32x2*)(m2 + (size_t)(RB) * D_ + i * 256 + lane * 4)); } } while (0)
    int idx = blockIdx.x * 8 + wid;
    f32x4 al[4]; int curb = -1;
#pragma unroll
    for (int i = 0; i < 4; ++i) al[i] = (f32x4){0.f, 0.f, 0.f, 0.f};
    if (idx < 16384) { FOLD_ROWS(idx, b0_, s0_, ra0_, rb0_); (void)b0_; (void)s0_; FOLD_LOAD(x, mw, mw2, ra0_, rb0_); }
    for (; idx < 16384; idx += nW) {
        FOLD_ROWS(idx, b, sq, rA, rB);
        f32x4 xn[2][4]; u32x2 mn[2][4], mn2[2][4];
        const int nidx = idx + nW;
        if (nidx < 16384) { FOLD_ROWS(nidx, b1_, s1_, ra1_, rb1_); (void)b1_; (void)s1_; FOLD_LOAD(xn, mn, mn2, ra1_, rb1_); }
        if (b != curb) {
            if (curb >= 0) {
#pragma unroll
                for (int i = 0; i < 4; ++i)
#pragma unroll
                    for (int j = 0; j < 4; ++j) atomicAdd(alt + curb * 1024 + i * 256 + lane * 4 + j, al[i][j]); }
#pragma unroll
            for (int i = 0; i < 4; ++i) al[i] = (f32x4){0.f, 0.f, 0.f, 0.f};
            curb = b;
        }
        f32x4 hv[2][4];
#pragma unroll
        for (int r = 0; r < 2; ++r) { const int row = r ? rB : rA;
            f32x4 mv[4]; float ss = 0.f;
#pragma unroll
            for (int i = 0; i < 4; ++i) { const u32x2 w = mw[r][i];
                mv[i] = (f32x4){bflo(w.x), bfhi(w.x), bflo(w.y), bfhi(w.y)}; ss += mv[i][0] * mv[i][0] + mv[i][1] * mv[i][1] + mv[i][2] * mv[i][2] + mv[i][3] * mv[i][3]; }
            ss = wave_sum(ss); const float rr = __builtin_amdgcn_rsqf(ss * (1.0f / D_) + EPS_);
#pragma unroll
            for (int i = 0; i < 4; ++i) { const f32x4 gp = *(const f32x4*)(gpost + i * 256 + lane * 4); x[r][i] += mv[i] * rr * gp; }
            float sb = 0.f;
#pragma unroll
            for (int i = 0; i < 4; ++i) { const u32x2 w = mw2[r][i];
                mv[i] = (f32x4){bflo(w.x), bfhi(w.x), bflo(w.y), bfhi(w.y)}; sb += mv[i][0] * mv[i][0] + mv[i][1] * mv[i][1] + mv[i][2] * mv[i][2] + mv[i][3] * mv[i][3]; }
            sb = wave_sum(sb); const float rb = __builtin_amdgcn_rsqf(sb * (1.0f / D_) + EPS_);
            float s2 = 0.f;
#pragma unroll
            for (int i = 0; i < 4; ++i) { const f32x4 gp = *(const f32x4*)(gpost2 + i * 256 + lane * 4); x[r][i] += mv[i] * rb * gp; __builtin_nontemporal_store(x[r][i], (f32x4*)(xout + (size_t)row * D_ + i * 256 + lane * 4));
                s2 += x[r][i][0] * x[r][i][0] + x[r][i][1] * x[r][i][1] + x[r][i][2] * x[r][i][2] + x[r][i][3] * x[r][i][3]; }
            s2 = wave_sum(s2); const float r2 = __builtin_amdgcn_rsqf(s2 * (1.0f / D_) + EPS_);
#pragma unroll
            for (int i = 0; i < 4; ++i) { const f32x4 gn = *(const f32x4*)(gnext + i * 256 + lane * 4); hv[r][i] = x[r][i] * r2 * gn; }
        }
        const float sg = (sq & 1) ? -1.f : 1.f;
#pragma unroll
        for (int i = 0; i < 4; ++i) { const f32x4 he = sq ? hv[0][i] + hv[1][i] : hv[0][i]; const f32x4 ho = sq ? hv[0][i] - hv[1][i] : (f32x4){0.f, 0.f, 0.f, 0.f};
            al[i] += sq ? he * sg : hv[0][i] + hv[1][i];
            u32x2 w; w.x = cvt_pk_bf16(he[0], he[1]); w.y = cvt_pk_bf16(he[2], he[3]); *(u32x2*)(He + ((size_t)b * 2048 + sq) * D_ + i * 256 + lane * 4) = w;
            w.x = cvt_pk_bf16(ho[0], ho[1]); w.y = cvt_pk_bf16(ho[2], ho[3]); *(u32x2*)(Ho + ((size_t)b * 2048 + sq) * D_ + i * 256 + lane * 4) = w;
            if (sq == 0) *(f32x4*)(h2048 + b * 1024 + i * 256 + lane * 4) = hv[1][i]; }
#pragma unroll
        for (int r = 0; r < 2; ++r)
#pragma unroll
            for (int i = 0; i < 4; ++i) { x[r][i] = xn[r][i]; mw[r][i] = mn[r][i]; mw2[r][i] = mn2[r][i]; }
    }
    if (curb >= 0) {
#pragma unroll
        for (int i = 0; i < 4; ++i)
#pragma unroll
            for (int j = 0; j < 4; ++j) atomicAdd(alt + curb * 1024 + i * 256 + lane * 4 + j, al[i][j]); }
#undef FOLD_ROWS
#undef FOLD_LOAD
}

#define LANE_TID const int lane = lane_id_asm(); const int wid = wave_s; const int tid = wid * 64 + lane; (void)tid; (void)lane; (void)wid
enum { PH_PREP = 0, PH_G1, PH_CONV, PH_GATES, PH_ATTN, PH_SCAN2, PH_MIXOUT, PH_ROW1, PH_FFN1, PH_FFN2, PH_ROW2, PH_DFTC, PH_DFTS, PH_FOUT, PH_PRE, PH_DFTQ };
constexpr int N_PHASES = 1 + 10 + 7 + 10 + 7;

DI void decode_phase(int ph, int& type, int& layer) {
    if (ph == 0) { type = PH_PREP; layer = 0; return; }
    int p = ph - 1;
    if (p < 10) { layer = 0; type = PH_G1 + p; return; }
    p -= 10;
    if (p < 7) { layer = 1; type = p < 3 ? PH_DFTC + p : PH_ROW1 + (p - 3); return; }
    p -= 7;
    if (p < 10) { layer = 2; type = PH_G1 + p; return; }
    p -= 10;
    layer = 3; type = p < 3 ? PH_DFTC + p : PH_ROW1 + (p - 3);
}

__global__ void __launch_bounds__(512, 2) fwd_megakernel(Params Pk) {
    extern __shared__ __attribute__((aligned(16))) unsigned char shm[];
    LAS unsigned char* lds = (LAS unsigned char*)shm;
    cg::grid_group grid = cg::this_grid();
    const int ph_lo = Pk.ph_lo, ph_hi = Pk.ph_hi;
    const int wave_s = __builtin_amdgcn_readfirstlane((int)(threadIdx.x >> 6));
    if (threadIdx.x < 4) ((volatile LAS unsigned*)(lds + LDS_BARW))[threadIdx.x] = 0u;
    __syncthreads();
    if (threadIdx.x == 0) (void)xb_add(&((unsigned*)(Pk.ws + WS_MISC + MI_BAR))[XB_XCNT(xb_xcc_id())], 1u);
    for (int ph = ph_lo; ph < ph_hi; ++ph) {
        typedef const __attribute__((address_space(4))) Params* KP;
        KP pp = (KP)__builtin_amdgcn_kernarg_segment_ptr(); asm volatile("" : "+s"(pp));
        const __attribute__((address_space(4))) Params& P = *pp;
        unsigned char* ws = P.ws; asm volatile("" : "+s"(ws));
        bf16_t* WIN = (bf16_t*)(ws + WS_WIN); bf16_t* WOUT = (bf16_t*)(ws + WS_WOUT); bf16_t* WF = (bf16_t*)(ws + WS_WF);
        bf16_t* WGU = (bf16_t*)(ws + WS_WGU); bf16_t* WD = (bf16_t*)(ws + WS_WD); bf16_t* WLRU = (bf16_t*)(ws + WS_WLRU); bf16_t* WDFT = (bf16_t*)(ws + WS_WDFT);
        float* NLS = (float*)(ws + WS_MISC + MI_NLS); float* LAMV = (float*)(ws + WS_MISC + MI_LAM); unsigned* KMAX = (unsigned*)(ws + WS_MISC + MI_KMAX);
        f32x2* AGG = (f32x2*)(ws + WS_MISC + MI_AGG);
        bf16_t* HN = (bf16_t*)(ws + WS_A); bf16_t* CAT = HN;
        bf16_t* QB = (bf16_t*)(ws + WS_B); bf16_t* KB = QB + (size_t)T_ * 512; bf16_t* VT = KB + (size_t)T_ * 512; bf16_t* XR = VT + (size_t)T_ * 512;
        float* HF = (float*)(ws + WS_B); bf16_t* FB = (bf16_t*)(ws + WS_B);
        bf16_t* DM = (bf16_t*)(ws + WS_B + 64 * MiB); bf16_t* MB = DM;
        bf16_t* GY = (bf16_t*)(ws + WS_GY);
        bf16_t* CSM = (bf16_t*)(ws + WS_CS); float* Y2048 = (float*)(ws + WS_MISC + MI_Y2048); bf16_t* YE = (bf16_t*)(ws + WS_E + 64 * MiB); bf16_t* HE = (bf16_t*)(ws + WS_E); bf16_t* HO = (bf16_t*)(ws + WS_E + 32 * MiB); float* ALT0 = (float*)(ws + WS_MISC + MI_ALT); float* H2048 = (float*)(ws + WS_MISC + MI_H2048); float* PM = (float*)(ws + WS_B + 64 * MiB);
        unsigned* AU = (unsigned*)(ws + WS_E); bf16_t* XC = (bf16_t*)(ws + WS_E + 128 * MiB); bf16_t* ACT = (bf16_t*)(ws + WS_E); bf16_t* YT = (bf16_t*)(ws + WS_E);

        const int code_ = P.tab[ph]; const int type = code_ & 15, l = (code_ >> 4) & 3, pflag = code_ >> 6;
        const int e = l >> 1;
        float* ALT = ALT0 + e * 8192;
#ifdef ONLY_PHASE
        if (type != ONLY_PHASE) continue;
#endif
        switch (type) {
        case PH_PREP: { LANE_TID;
            LAS float* tl = (LAS float*)lds;
            for (int ee = 0; ee < 2; ++ee) {
                transpose_cvt(tid, tl, P.in[5] + (size_t)ee * D_ * INC_, D_, INC_, WIN + (size_t)ee * INC_ * D_, D_, 3);
                transpose_cvt(tid, tl, P.in[6] + (size_t)ee * D_ * D_, D_, D_, WOUT + (size_t)ee * D_ * D_, D_, 0);
                transpose_cvt(tid, tl, P.in[19] + (size_t)ee * D_ * D_, D_, D_, WF + (size_t)ee * D_ * D_, D_, 0);
            }
            for (int ll = 0; ll < 4; ++ll) {
                transpose_cvt(tid, tl, P.in[20] + (size_t)ll * D_ * FF_, D_, FF_, WGU + (size_t)ll * 2 * FF_ * D_, D_, 1);
                transpose_cvt(tid, tl, P.in[21] + (size_t)ll * D_ * FF_, D_, FF_, WGU + (size_t)ll * 2 * FF_ * D_, D_, 2);
                transpose_cvt(tid, tl, P.in[22] + (size_t)ll * FF_ * D_, FF_, D_, WD + (size_t)ll * D_ * FF_, FF_, 0);
            }
            const int gtid = blockIdx.x * 512 + tid, gn = gridDim.x * 512;
            for (int idx = gtid; idx < 2 * 4 * 512 * 256; idx += gn) {
                const int k = idx & 255, row = (idx >> 8) & 511, h = (idx >> 17) & 3, ee = idx >> 19;
                const int dir = row >> 8, gate = (row >> 7) & 1, j = row & 127;
                float v = 0.f;
                if (k < 128) v = (gate ? P.in[16] : P.in[14])[((size_t)((ee * 2 + dir) * 4 + h) * 128 + k) * 128 + j];
                WLRU[idx] = (bf16_t)(cvt_pk_bf16(v, 0.f) & 0xffffu);
            }
            for (int idx = gtid; idx < 512 * 256; idx += gn) {
                const int c = idx & 255, n = (idx >> 8) & 255, part = idx >> 16;
                const float ang = (float)((n * c) & 255) * (1.0f / 128.0f); float sv, cv; sincospif(ang, &sv, &cv);
                WDFT[idx] = (bf16_t)(cvt_pk_bf16((part ? sv : cv) * 0.0625f, 0.f) & 0xffffu);
            }
            for (int idx = gtid; idx < 2 * 2048 * 256; idx += gn) {
                const int s0 = (idx & 255) * 8, k = (idx >> 8) & 2047, part = idx >> 19; float v[8];
#pragma unroll
                for (int j = 0; j < 8; ++j) { const int p = (k * (s0 + j)) & 4095; float sv, cv; sincospif((float)p * (1.0f / 2048.0f), &sv, &cv); v[j] = (part ? sv : cv) * (1.0f / 64.0f); }
                u32x4 w; w.x = cvt_pk_bf16(v[0], v[1]); w.y = cvt_pk_bf16(v[2], v[3]); w.z = cvt_pk_bf16(v[4], v[5]); w.w = cvt_pk_bf16(v[6], v[7]);
                *(u32x4*)(CSM + (size_t)idx * 8) = w;
            }
            for (int idx = gtid; idx < 2 * 2 * 512; idx += gn) { const float x = P.in[18][idx]; NLS[idx] = -8.0f * __builtin_amdgcn_logf(1.0f + __builtin_amdgcn_exp2f(-x * LOG2E)); }
            if (blockIdx.x == 0 && tid < 128) KMAX[tid] = 0u;
            for (int idx = gtid; idx < 2 * 8192; idx += gn) ((float*)(ws + WS_MISC + MI_ALT))[idx] = 0.f;
            if (blockIdx.x == 0 && wid < 2) {
                const float a = wave_sum(P.in[7][wid * 64 + lane] * P.in[8][wid * 64 + lane]);
                const float b = wave_sum(P.in[9][wid * 64 + lane] * P.in[10][wid * 64 + lane]);
                int wq = wid; asm volatile("" : "+s"(wq)); const float li = wq == 0 ? 0.2f : 0.47071302f;
                if (lane == 0) LAMV[wid] = __builtin_amdgcn_exp2f(a * LOG2E) - __builtin_amdgcn_exp2f(b * LOG2E) + li;
            }
            rowpass(tid, P.in[0], nullptr, nullptr, nullptr, P.in[1], HN);
        } break;

        case PH_G1: { LANE_TID;
            pg8::Gemm g{HN, WIN + (size_t)e * INC_ * D_, D_, D_, D_, T_ / 256, INC_ / 256, 1, 0, 0};
            g.A2 = WIN + (size_t)e * INC_ * D_ + (size_t)2048 * D_; g.swapN = 8;
            pg8::EpiG1 E{QB, KB, VT, XR, GY};
            pg8::gemm_phase(lds, g, E, tid);
        } break;

        case PH_CONV: { LANE_TID;
            const float* cw = P.in[12] + (size_t)e * 4 * 512; const float* cb = P.in[13] + (size_t)e * 512;
            const int ch = lane * 8;
            float w[4][8], bb[8];
#pragma unroll
            for (int j = 0; j < 4; ++j)
#pragma unroll
                for (int i = 0; i < 8; ++i) w[j][i] = cw[j * 512 + ch + i];
#pragma unroll
            for (int i = 0; i < 8; ++i) bb[i] = cb[ch + i];
            for (int tb = blockIdx.x; tb < 256; tb += gridDim.x) {
                float kmx = 0.f;
                for (int it = 0; it < 4; ++it) {
                    const int t0 = tb * 128 + it * 32 + wid * 4, s0 = t0 & 4095;
                    u32x4 xr7[7], kv4[4];
#pragma unroll
                    for (int r = 0; r < 7; ++r) { const int ss = s0 + r - 2; xr7[r] = (u32x4){0u, 0u, 0u, 0u};
                        if (ss >= 0 && ss < S_) xr7[r] = *(const u32x4*)(XR + (size_t)(t0 + r - 2) * 512 + ch); }
#pragma unroll
                    for (int q = 0; q < 4; ++q) kv4[q] = *(const u32x4*)(KB + (size_t)(t0 + q) * 512 + ch);
#pragma unroll
                    for (int q = 0; q < 4; ++q) {
                        float accv[8];
#pragma unroll
                        for (int i = 0; i < 8; ++i) accv[i] = bb[i];
#pragma unroll
                        for (int j = 0; j < 4; ++j) { const u32x4 xv = xr7[q + j];
                            accv[0] += w[j][0] * bflo(xv.x); accv[1] += w[j][1] * bfhi(xv.x); accv[2] += w[j][2] * bflo(xv.y); accv[3] += w[j][3] * bfhi(xv.y);
                            accv[4] += w[j][4] * bflo(xv.z); accv[5] += w[j][5] * bfhi(xv.z); accv[6] += w[j][6] * bflo(xv.w); accv[7] += w[j][7] * bfhi(xv.w); }
                        u32x4 o; o.x = cvt_pk_bf16(accv[0], accv[1]); o.y = cvt_pk_bf16(accv[2], accv[3]); o.z = cvt_pk_bf16(accv[4], accv[5]); o.w = cvt_pk_bf16(accv[6], accv[7]);
                        *(u32x4*)(XC + (size_t)(t0 + q) * 512 + ch) = o;
                        const u32x4 kv = kv4[q];
                        float q2 = bflo(kv.x) * bflo(kv.x) + bfhi(kv.x) * bfhi(kv.x) + bflo(kv.y) * bflo(kv.y) + bfhi(kv.y) * bfhi(kv.y)
                                 + bflo(kv.z) * bflo(kv.z) + bfhi(kv.z) * bfhi(kv.z) + bflo(kv.w) * bflo(kv.w) + bfhi(kv.w) * bfhi(kv.w);
                        q2 += __shfl_xor(q2, 1); q2 += __shfl_xor(q2, 2); q2 += __shfl_xor(q2, 4);
                        kmx = fmaxf(kmx, q2);
                    }
                }
                if ((lane & 7) == 0) atomicMax(KMAX + e * 64 + (tb >> 5) * 8 + (lane >> 3), __float_as_uint(kmx));
            }
        } break;

        case PH_GATES: { LANE_TID;
            int kg_ = 128; asm volatile("" : "+s"(kg_));
            pg8::Gemm g{XC, WLRU + (size_t)e * 4 * 512 * 256, 512, 256, kg_, T_ / 256, 2, 4, 128, 512 * 256};
            pg8::EpiGates E{XC, P.in[15] + (size_t)e * 1024, P.in[17] + (size_t)e * 1024, NLS + e * 1024, AU};
            pg8::gemm_phase(lds, g, E, tid);
        } break;

        case PH_ATTN: { LANE_TID;
            for (int idx = blockIdx.x * 512 + tid; idx < 2 * 8 * 32 * 512; idx += gridDim.x * 512) {
                const int c = idx & 511, chunk = (idx >> 9) & 31, b = (idx >> 14) & 7, dir = idx >> 17;
                const unsigned* p = AU + ((size_t)dir * T_ + b * S_ + chunk * 128) * 512 + c;
                float LA = 0.f, H = 0.f;
                for (int s0 = 0; s0 < 128; s0 += 32) {
                    unsigned w[32];
#pragma unroll
                    for (int i = 0; i < 32; ++i) { const int s = dir == 0 ? (s0 + i) : (127 - s0 - i); w[i] = p[(size_t)s * 512]; }
#pragma unroll
                    for (int i = 0; i < 32; ++i) { const float la = bflo(w[i]); LA += la; H = __builtin_amdgcn_exp2f(la) * H + bfhi(w[i]); }
                }
                AGG[(((size_t)b * 32 + chunk) * 512 + c) * 2 + dir] = (f32x2){LA, H};
            }
            const int fr = lane & 15, fq = lane >> 4;
            const float lamv = LAMV[e];
            const float lam_init = l == 0 ? 0.2f : 0.47071302f;
            constexpr int KBUF = 16384, VBUF = 16384, BUFB = KBUF + VBUF;
            unsigned* AQ = (unsigned*)(ws + WS_MISC + MI_BAR) + (e * 8 + (int)(blockIdx.x & 7));
            LAS int* qslot = (LAS int*)(lds + LDS_MBW + 32);
            __syncthreads();
            if (tid == 0) *qslot = (int)atomicAdd(AQ, 1u);
            __syncthreads();
            int n_cur = *qslot;
            while (n_cur < 128) {
                unsigned n_nxt = 0u; if (tid == 0) n_nxt = atomicAdd(AQ, 1u);
                const int h = 3 - (n_cur >> 5), qb = n_cur & 31, b = (int)(blockIdx.x & 7);
                const int tok0 = b * S_, q0 = qb * 128 + wid * 16;
                const float slope2 = __builtin_amdgcn_exp2f(-2.0f * (float)(h + 1)) * LOG2E;
                bf16x8 Qf[2][2];
                float mb = 0.f, gap = 0.f;
#pragma unroll
                for (int mm = 0; mm < 2; ++mm) { float q2 = 0.f, sii = 0.f;
#pragma unroll
                    for (int ks = 0; ks < 2; ++ks) { Qf[mm][ks] = *(const bf16x8*)(QB + (size_t)(tok0 + q0 + fr) * 512 + h * 128 + mm * 64 + ks * 32 + fq * 8);
                        const bf16x8 kd = *(const bf16x8*)(KB + (size_t)(tok0 + q0 + fr) * 512 + h * 128 + mm * 64 + ks * 32 + fq * 8);
#pragma unroll
                        for (int j = 0; j < 8; ++j) { const float v = bf2f((unsigned short)Qf[mm][ks][j]); q2 += v * v; sii += v * bf2f((unsigned short)kd[j]); } }
                    q2 += __shfl_xor(q2, 16); q2 += __shfl_xor(q2, 32); sii += __shfl_xor(sii, 16); sii += __shfl_xor(sii, 32);
                    const float k2 = __uint_as_float(KMAX[e * 64 + b * 8 + h * 2 + mm]);
                    const float bm = __builtin_sqrtf(q2 * k2);
                    mb = fmaxf(mb, bm); gap = fmaxf(gap, bm - sii); }
                const f32x4 cinit = (f32x4){-mb, -mb, -mb, -mb};
                const float qf = (float)(q0 + fr);
                f32x4 o[2][8]; float lsum[2] = {0.f, 0.f};
#pragma unroll
                for (int mm = 0; mm < 2; ++mm)
#pragma unroll
                    for (int blk = 0; blk < 8; ++blk) o[mm][blk] = (f32x4){0.f, 0.f, 0.f, 0.f};
                const char* kbase = (const char*)(KB + (size_t)tok0 * 512 + h * 128); const char* vbase = (const char*)(VT + (size_t)(b * 512 + h * 128) * S_);
                unsigned goff[4];
#pragma unroll
                for (int i = 0; i < 4; ++i) { const int sg = ((wid & 3) * 4 + i) * 64 + lane, p = sg >> 8, w = sg & 255;
                    if (wid < 4) { const int lam = w >> 2, cpos = (w & 3) ^ ((lam >> 2) & 3);
                        const int key = (lam & 32) + 8 * ((lam & 15) >> 2) + 4 * ((lam >> 4) & 1) + (lam & 3); goff[i] = (unsigned)(key * 1024 + (cpos * 4 + p) * 16); }
                    else { const int d = w >> 1, kgp = (w & 1) ^ ((d >> 3) & 1); goff[i] = (unsigned)(d * 8192 + (kgp * 4 + p) * 16); } }
                unsigned kro[4], vro[2];
#pragma unroll
                for (int cp = 0; cp < 4; ++cp) kro[cp] = (unsigned)(fq * 4096 + fr * 64 + ((cp ^ ((fr >> 2) & 3)) << 4));
#pragma unroll
                for (int kg = 0; kg < 2; ++kg) vro[kg] = (unsigned)(fq * 4096 + fr * 32 + ((kg ^ ((fr >> 3) & 1)) << 4));
#define ATT_DMA(tt, sl) do { const char* gb_ = (wid < 4) ? (kbase + (size_t)(tt) * 65536) : (vbase + (size_t)(tt) * 128); \
                    _Pragma("unroll") for (int i = 0; i < 4; ++i) \
                        __builtin_amdgcn_global_load_lds((const unsigned*)(gb_ + goff[i]), (LAS unsigned*)(lds + (sl) * BUFB + (wid * 4 + i) * 1024), 16, 0, 0); } while (0)
#define ATT_WAIT_TILE() do { if (wid == 7) asm volatile("s_waitcnt vmcnt(2)" ::: "memory"); else asm volatile("s_waitcnt vmcnt(6)" ::: "memory"); } while (0)
                __syncthreads();
                { float mw = gap; mw = fmaxf(mw, __shfl_xor(mw, 1)); mw = fmaxf(mw, __shfl_xor(mw, 2)); mw = fmaxf(mw, __shfl_xor(mw, 4)); mw = fmaxf(mw, __shfl_xor(mw, 8));
                  if (lane == 0) ((LAS float*)(lds + LDS_MBW))[wid] = mw; }
                __syncthreads();
                float mbmax = 0.f;
#pragma unroll
                for (int w8 = 0; w8 < 8; ++w8) mbmax = fmaxf(mbmax, ((const LAS float*)(lds + LDS_MBW))[w8]);
                const float d0f = fminf((fmaxf(mbmax, 0.f) + 50.0f) / slope2, 8192.0f);
                const int d0 = (int)d0f + 1;
                int t_lo = (qb * 128 - d0 + 1); t_lo = t_lo < 0 ? 0 : (t_lo >> 6);
                int t_hi = (qb * 128 + 127 + d0 - 1) >> 6; t_hi = t_hi > 63 ? 63 : t_hi;
                t_lo = __builtin_amdgcn_readfirstlane(t_lo); t_hi = __builtin_amdgcn_readfirstlane(t_hi);
#define ATT_SOFTMAX(tt, kg, P8x) do { _Pragma("unroll") for (int ti = 0; ti < 2; ++ti) { const float dq = qf - (float)((tt) * 64 + (kg) * 32 + ti * 4 + fq * 8); \
                        _Pragma("unroll") for (int j = 0; j < 4; ++j) { const float bias = slope2 * __builtin_fabsf(dq - (float)j); \
                            _Pragma("unroll") for (int mm = 0; mm < 2; ++mm) { const float p = __builtin_amdgcn_exp2f(st[kg][mm][ti][j] - bias); st[kg][mm][ti][j] = p; lsum[mm] += p; } } } \
                        _Pragma("unroll") for (int mm = 0; mm < 2; ++mm) { u32x4 w; w.x = cvt_pk_nv(st[kg][mm][0][0], st[kg][mm][0][1]); w.y = cvt_pk_nv(st[kg][mm][0][2], st[kg][mm][0][3]); \
                            w.z = cvt_pk_nv(st[kg][mm][1][0], st[kg][mm][1][1]); w.w = cvt_pk_nv(st[kg][mm][1][2], st[kg][mm][1][3]); P8x[mm] = __builtin_bit_cast(bf16x8, w); } } while (0)
#define ATT_H1(tt, sl) do { const LAS unsigned char* kl = lds + (sl) * BUFB; bf16x8 kf[2][2][2][2]; \
                    _Pragma("unroll") for (int kg = 0; kg < 2; ++kg) _Pragma("unroll") for (int ti = 0; ti < 2; ++ti) _Pragma("unroll") for (int mm = 0; mm < 2; ++mm) _Pragma("unroll") for (int ks = 0; ks < 2; ++ks) \
                        kf[kg][ti][mm][ks] = *(const LAS bf16x8*)(kl + kro[mm * 2 + ks] + (kg * 32 + ti * 16) * 64); \
                    __builtin_amdgcn_sched_barrier(0); \
                    f32x4 st[2][2][2]; __builtin_amdgcn_s_setprio(1); \
                    _Pragma("unroll") for (int kg = 0; kg < 2; ++kg) _Pragma("unroll") for (int ti = 0; ti < 2; ++ti) _Pragma("unroll") for (int mm = 0; mm < 2; ++mm) \
                        st[kg][mm][ti] = __builtin_amdgcn_mfma_f32_16x16x32_bf16(kf[kg][ti][mm][0], Qf[mm][0], cinit, 0, 0, 0); \
                    _Pragma("unroll") for (int kg = 0; kg < 2; ++kg) _Pragma("unroll") for (int ti = 0; ti < 2; ++ti) _Pragma("unroll") for (int mm = 0; mm < 2; ++mm) \
                        st[kg][mm][ti] = __builtin_amdgcn_mfma_f32_16x16x32_bf16(kf[kg][ti][mm][1], Qf[mm][1], st[kg][mm][ti], 0, 0, 0); \
                    __builtin_amdgcn_s_setprio(0); __builtin_amdgcn_sched_barrier(0); \
                    ATT_SOFTMAX(tt, 0, P8a); ATT_SOFTMAX(tt, 1, P8b); \
                    __builtin_amdgcn_sched_barrier(0); } while (0)
#define ATT_H2(sl) do { const LAS unsigned char* vl = lds + (sl) * BUFB + KBUF; bf16x8 vf0[8], vf1[8]; \
                    _Pragma("unroll") for (int blk = 0; blk < 8; ++blk) vf0[blk] = *(const LAS bf16x8*)(vl + vro[0] + blk * 512); \
                    _Pragma("unroll") for (int blk = 0; blk < 8; ++blk) vf1[blk] = *(const LAS bf16x8*)(vl + vro[1] + blk * 512); \
                    __builtin_amdgcn_sched_barrier(0); __builtin_amdgcn_s_setprio(1); \
                    _Pragma("unroll") for (int blk = 0; blk < 8; ++blk) { \
                        o[0][blk] = __builtin_amdgcn_mfma_f32_16x16x32_bf16(vf0[blk], P8a[0], o[0][blk], 0, 0, 0); \
                        o[1][blk] = __builtin_amdgcn_mfma_f32_16x16x32_bf16(vf0[blk], P8a[1], o[1][blk], 0, 0, 0); } \
                    _Pragma("unroll") for (int blk = 0; blk < 8; ++blk) { \
                        o[0][blk] = __builtin_amdgcn_mfma_f32_16x16x32_bf16(vf1[blk], P8b[0], o[0][blk], 0, 0, 0); \
                        o[1][blk] = __builtin_amdgcn_mfma_f32_16x16x32_bf16(vf1[blk], P8b[1], o[1][blk], 0, 0, 0); } \
                    __builtin_amdgcn_s_setprio(0); __builtin_amdgcn_sched_barrier(0); } while (0)
                const int ntl = t_hi - t_lo + 1;
                const bool lag = wid >= 4;
                bf16x8 P8a[2], P8b[2];
                P8a[0] = P8a[1] = P8b[0] = P8b[1] = (bf16x8){0, 0, 0, 0, 0, 0, 0, 0};
                ATT_DMA(t_lo, 0);
                int slot = 0, pslot = 2;
                for (int it = 0; it <= ntl; ++it) {
                    asm volatile("s_waitcnt vmcnt(0)" ::: "memory");
                    __builtin_amdgcn_s_barrier(); asm volatile("" ::: "memory");
                    const int nslot = slot == 2 ? 0 : slot + 1;
                    if (it + 1 < ntl) ATT_DMA(t_lo + it + 1, nslot);
                    if (lag && it > 0) ATT_H2(pslot);
                    if (it < ntl) ATT_H1(t_lo + it, slot);
                    if (!lag && it < ntl) ATT_H2(slot);
                    pslot = slot; slot = nslot;
                }
#undef ATT_SOFTMAX
#undef ATT_H1
#undef ATT_H2
                asm volatile("s_waitcnt vmcnt(0)" ::: "memory");
#undef ATT_DMA
#undef ATT_WAIT_TILE
                float l0 = lsum[0], l1 = lsum[1];
                l0 += __shfl_xor(l0, 16); l0 += __shfl_xor(l0, 32); l1 += __shfl_xor(l1, 16); l1 += __shfl_xor(l1, 32);
                const float i0 = 1.0f / l0, i1 = lamv / l1;
                float ss = 0.f;
#pragma unroll
                for (int blk = 0; blk < 8; ++blk)
#pragma unroll
                    for (int j = 0; j < 4; ++j) { const float v = o[0][blk][j] * i0 - o[1][blk][j] * i1; o[0][blk][j] = v; ss += v * v; }
                ss += __shfl_xor(ss, 16); ss += __shfl_xor(ss, 32);
                const float rn = __builtin_amdgcn_rsqf(ss * (1.0f / 128.0f) + EPS_) * (1.0f - lam_init);
                const float* sg = P.in[11] + e * 128;
                bf16_t* op = CAT + (size_t)(tok0 + q0 + fr) * D_ + h * 128 + fq * 4;
#pragma unroll
                for (int blk = 0; blk < 8; ++blk) { const f32x4 gv = *(const f32x4*)(sg + blk * 16 + fq * 4);
                    u32x2 w; w.x = cvt_pk_bf16(o[0][blk][0] * rn * gv[0], o[0][blk][1] * rn * gv[1]); w.y = cvt_pk_bf16(o[0][blk][2] * rn * gv[2], o[0][blk][3] * rn * gv[3]);
                    *(u32x2*)(op + blk * 16) = w; }
                __syncthreads();
                if (tid == 0) *qslot = (int)n_nxt;
                __syncthreads();
                n_cur = *qslot;
            }
        } break;

        case PH_SCAN2: { LANE_TID;
            for (int idx = blockIdx.x * 512 + tid; idx < 8 * 32 * 512; idx += gridDim.x * 512) {
                const int c = idx & 511, chunk = (idx >> 9) & 31, b = idx >> 14;
                const size_t tbase = (size_t)b * S_ + chunk * 128;
                float H = 0.f;
                for (int cc = 0; cc < chunk; ++cc) { const f32x2 ag = AGG[(((size_t)b * 32 + cc) * 512 + c) * 2 + 0]; H = __builtin_amdgcn_exp2f(ag.x) * H + ag.y; }
                float hfr[128];
                { const unsigned* p = AU + tbase * 512 + c;
#pragma unroll
                  for (int s0 = 0; s0 < 128; s0 += 32) {
                      unsigned w[32];
#pragma unroll
                      for (int i = 0; i < 32; ++i) w[i] = __builtin_nontemporal_load(p + (size_t)(s0 + i) * 512);
#pragma unroll
                      for (int i = 0; i < 32; ++i) { H = __builtin_amdgcn_exp2f(bflo(w[i])) * H + bfhi(w[i]); hfr[s0 + i] = H; }
                  } }
                H = 0.f;
                for (int cc = 31; cc > chunk; --cc) { const f32x2 ag = AGG[(((size_t)b * 32 + cc) * 512 + c) * 2 + 1]; H = __builtin_amdgcn_exp2f(ag.x) * H + ag.y; }
                { const unsigned* p = AU + ((size_t)T_ + tbase) * 512 + c; const bf16_t* gp = GY + tbase * 512 + c; bf16_t* op = CAT + tbase * D_ + 512 + c;
#pragma unroll
                  for (int s0 = 127; s0 >= 0; s0 -= 16) {
                      unsigned w[16]; unsigned short gv[16];
#pragma unroll
                      for (int i = 0; i < 16; ++i) { const size_t s = (size_t)(s0 - i); w[i] = __builtin_nontemporal_load(p + s * 512); gv[i] = __builtin_nontemporal_load(gp + s * 512); }
#pragma unroll
                      for (int i = 0; i < 16; ++i) { H = __builtin_amdgcn_exp2f(bflo(w[i])) * H + bfhi(w[i]);
                          const float rec = (hfr[s0 - i] + H) * bf2f(gv[i]); op[(size_t)(s0 - i) * D_] = (bf16_t)(cvt_pk_bf16(rec, 0.f) & 0xffffu); }
                  } }
            }
        } break;

        case PH_MIXOUT: { LANE_TID;
            pg8::Gemm g{CAT, WOUT + (size_t)e * D_ * D_, D_, D_, D_, T_ / 256, D_ / 256, 1, 0, 0};
            pg8::EpiPlain E{MB, D_, 0};
            pg8::gemm_phase(lds, g, E, tid);
        } break;
        case PH_FOUT: { LANE_TID;
            pg8::Gemm g{FB, WF + (size_t)e * D_ * D_, D_, D_, D_, T_ / 256, D_ / 256, 1, 0, 0};
            pg8::EpiPlain E{MB, D_, 0};
            pg8::gemm_phase(lds, g, E, tid);
        } break;
        case PH_FFN2: { LANE_TID;
            pg8::Gemm g{ACT, WD + (size_t)l * D_ * FF_, FF_, FF_, FF_, T_ / 256, D_ / 256, 1, 0, 0};
            pg8::EpiPlain E{FB, D_, 0};
            pg8::gemm_phase(lds, g, E, tid);
        } break;
        case PH_PRE: { LANE_TID;
            const int chn = (tid & 127) * 8, sl = tid >> 7;
            for (int wgi = blockIdx.x; wgi < 256; wgi += gridDim.x) {
                const int b = wgi >> 5, sbase = (wgi & 31) * 64;
                float al[8];
#pragma unroll
                for (int i = 0; i < 8; ++i) al[i] = 0.f;
                for (int it4 = 0; it4 < 4; ++it4) {
                    u32x4 av4[4], bv4[4];
#pragma unroll
                    for (int u4 = 0; u4 < 4; ++u4) { const int sq = sbase + (it4 * 4 + u4) * 4 + sl;
                        av4[u4] = __builtin_nontemporal_load((const u32x4*)(HN + ((size_t)b * S_ + sq) * D_ + chn));
                        bv4[u4] = (u32x4){0u, 0u, 0u, 0u};
                        if (sq) bv4[u4] = __builtin_nontemporal_load((const u32x4*)(HN + ((size_t)b * S_ + (S_ - sq)) * D_ + chn)); }
#pragma unroll
                    for (int u4 = 0; u4 < 4; ++u4) { const int sq = sbase + (it4 * 4 + u4) * 4 + sl; const u32x4 av = av4[u4], bv = bv4[u4];
                        const float a[8] = {bflo(av.x), bfhi(av.x), bflo(av.y), bfhi(av.y), bflo(av.z), bfhi(av.z), bflo(av.w), bfhi(av.w)};
                        const float m8[8] = {bflo(bv.x), bfhi(bv.x), bflo(bv.y), bfhi(bv.y), bflo(bv.z), bfhi(bv.z), bflo(bv.w), bfhi(bv.w)};
                        float he[8], ho[8]; const float sg = (sq & 1) ? -1.f : 1.f;
#pragma unroll
                        for (int i = 0; i < 8; ++i) { he[i] = a[i] + m8[i]; ho[i] = sq ? a[i] - m8[i] : 0.f; al[i] += sg * he[i]; }
                        u32x4 w; w.x = cvt_pk_bf16(he[0], he[1]); w.y = cvt_pk_bf16(he[2], he[3]); w.z = cvt_pk_bf16(he[4], he[5]); w.w = cvt_pk_bf16(he[6], he[7]);
                        *(u32x4*)(HE + ((size_t)b * 2048 + sq) * D_ + chn) = w;
                        w.x = cvt_pk_bf16(ho[0], ho[1]); w.y = cvt_pk_bf16(ho[2], ho[3]); w.z = cvt_pk_bf16(ho[4], ho[5]); w.w = cvt_pk_bf16(ho[6], ho[7]);
                        *(u32x4*)(HO + ((size_t)b * 2048 + sq) * D_ + chn) = w;
                        if (sq == 0) { const u32x4 cv = *(const u32x4*)(HN + ((size_t)b * S_ + 2048) * D_ + chn);
                            const float c8[8] = {bflo(cv.x), bfhi(cv.x), bflo(cv.y), bfhi(cv.y), bflo(cv.z), bfhi(cv.z), bflo(cv.w), bfhi(cv.w)};
#pragma unroll
                            for (int i = 0; i < 8; ++i) { al[i] += c8[i]; H2048[b * 1024 + chn + i] = c8[i]; } }
                    }
                }
#pragma unroll
                for (int i = 0; i < 8; ++i) atomicAdd(ALT + b * 1024 + chn + i, al[i]);
            }
        } break;
        case PH_DFTS: { LANE_TID;
            if (pflag) {
                pg8::Gemm g{CSM, YE, 2048, 4096, 2048, 8, 4, 16, 0, (long)1024 * 4096, 8, (long)2048 * 2048, 2048};
                pg8::EpiDftPQ E{PM, Y2048, FB};
                pg8::gemm_phase(lds, g, E, tid);
            } else {
                pg8::Gemm g{CSM, YE, 2048, 4096, 2048, 8, 4, 8, 0, (long)1024 * 4096};
                pg8::EpiF32 E{PM, D_, 2048};
                pg8::gemm_phase(lds, g, E, tid);
            }
        } break;
        case PH_DFTQ: { LANE_TID;
            pg8::Gemm g{CSM + (size_t)2048 * 2048, YE + 2048, 2048, 4096, 2048, 8, 4, 8, 0, (long)1024 * 4096};
            pg8::EpiDftQ E{PM, Y2048, FB};
            pg8::gemm_phase(lds, g, E, tid);
        } break;

        case PH_ROW1: { LANE_TID;
            rowpass(tid, l == 0 ? P.in[0] : P.out, nullptr, MB, P.in[2] + l * D_, P.in[3] + l * D_, HN);
        } break;
        case PH_ROW2: { LANE_TID;
            if (pflag) rowpass_fold(tid, l == 0 ? P.in[0] : P.out, P.out, MB, P.in[2] + l * D_, FB, P.in[4] + l * D_, P.in[1] + (l + 1) * D_, HE, HO, ALT0 + (l >> 1) * 8192, H2048);
            else rowpass(tid, P.out, P.out, MB, P.in[2] + l * D_, l < 3 ? P.in[1] + (l + 1) * D_ : nullptr, l < 3 ? HN : nullptr, FB, P.in[4] + l * D_);
        } break;

        case PH_FFN1: { LANE_TID;
            pg8::Gemm g{HN, WGU + (size_t)l * 2 * FF_ * D_, D_, D_, D_, T_ / 256, 2 * FF_ / 256, 1, 0, 0};
            pg8::EpiSwiglu E{ACT};
            pg8::gemm_phase(lds, g, E, tid);
        } break;

        case PH_DFTC: { LANE_TID;
            for (int task = blockIdx.x * 8 + wid; task < 8 * 1024; task += gridDim.x * 8) {
                const int b = task >> 10, col = task & 1023, gq = col >> 8, n = col & 255;
                const u32x2 wv = *(const u32x2*)(WDFT + (size_t)n * 256 + lane * 4);
                const f32x4 hv = *(const f32x4*)(H2048 + b * 1024 + gq * 256 + lane * 4), av = *(const f32x4*)(ALT + b * 1024 + gq * 256 + lane * 4);
                const float w0 = bflo(wv.x), w1 = bfhi(wv.x), w2 = bflo(wv.y), w3 = bfhi(wv.y);
                const float d1 = wave_sum(w0 * hv[0] + w1 * hv[1] + w2 * hv[2] + w3 * hv[3]);
                const float d2 = wave_sum(w0 * av[0] + w1 * av[1] + w2 * av[2] + w3 * av[3]);
                if (lane == 0) { Y2048[task] = d1; FB[((size_t)b * S_ + 2048) * D_ + col] = (bf16_t)(cvt_pk_bf16(d2 * (1.0f / 64.0f), 0.f) & 0xffffu); }
            }
            pg8::Gemm g{WDFT, HE, 256, D_, 256, 1, 8 * 2048 / 256, 8, 0, 256, 4, 256 * 256, (long)(32 * MiB / 2)};
            pg8::EpiDftC2 E{YE};
            pg8::gemm_phase(lds, g, E, tid);
        } break;
        default: break;
        }
        if (ph + 1 < ph_hi) {
            if (ph_hi < 0) grid.sync();
            else { const int ln_ = lane_id_asm();
                   xcd_barrier((unsigned*)(ws + WS_MISC + MI_BAR), (volatile LAS unsigned*)(lds + LDS_BARW), wave_s == 0 && ln_ == 0); }
        }
    }
}

extern "C" void kernel_launch(void* const* d_in, const int* in_sizes, int n_in, void* d_out, int out_size, void* d_ws, size_t ws_size, hipStream_t stream) {
    constexpr size_t kDynLds = LDS_TOTAL;
    static int grid_blocks = 0;
    if (!grid_blocks) {
        int dev = 0, cus = 0, per_cu = 0;
        hipGetDevice(&dev);
        hipDeviceGetAttribute(&cus, hipDeviceAttributeMultiprocessorCount, dev);
        hipFuncSetAttribute((const void*)fwd_megakernel, hipFuncAttributeMaxDynamicSharedMemorySize, (int)kDynLds);
        hipOccupancyMaxActiveBlocksPerMultiprocessor(&per_cu, fwd_megakernel, 512, kDynLds);
        if (per_cu < 1) per_cu = 1;
        grid_blocks = cus * per_cu;
        if (ws_size < WS_END) fprintf(stderr, "kernel_launch: workspace too small: %zu < %zu\n", ws_size, (size_t)WS_END);
    }
    (void)hipMemsetAsync((unsigned char*)d_ws + WS_MISC + MI_BAR, 0, BAR_BYTES, stream);
    Params p{};
    for (int i = 0; i < 23; ++i) p.in[i] = (const float*)d_in[i];
    p.out = (float*)d_out; p.ws = (unsigned char*)d_ws;
    int nph = 0;
    {
        auto add = [&](int type, int l) { p.tab[nph++] = (unsigned char)(type | (l << 4)); if ((PROBE_DUP >> type) & 1) p.tab[nph++] = (unsigned char)(type | (l << 4)); };
        add(PH_PREP, 0);
        for (int l = 0; l < 4; ++l) {
            if ((l & 1) == 0) { add(PH_G1, l); add(PH_CONV, l); add(PH_GATES, l); add(PH_ATTN, l); add(PH_SCAN2, l); add(PH_MIXOUT, l); }
            else { add(PH_DFTC, l); if (grid_blocks == 256) { add(PH_DFTS, l); p.tab[nph - 1] |= 64; } else { add(PH_DFTS, l); add(PH_DFTQ, l); } add(PH_FOUT, l); }
            add(PH_ROW1, l); add(PH_FFN1, l); add(PH_FFN2, l); add(PH_ROW2, l); if ((l & 1) == 0) p.tab[nph - 1] |= 64;
        }
    }
#if MULTI_LAUNCH
    for (int ph = 0; ph < nph; ++ph) {
        p.ph_lo = ph; p.ph_hi = ph + 1;
        void* args[] = {&p};
        hipError_t e = hipLaunchCooperativeKernel((void*)fwd_megakernel, dim3(grid_blocks), dim3(512), args, kDynLds, stream);
        if (e != hipSuccess) { fprintf(stderr, "cooperative launch failed: %s (grid %d)\n", hipGetErrorString(e), grid_blocks); break; }
    }
#else
    p.ph_lo = 0; p.ph_hi = nph;
    void* args[] = {&p};
    hipError_t e = hipLaunchCooperativeKernel((void*)fwd_megakernel, dim3(grid_blocks), dim3(512), args, kDynLds, stream);
    if (e != hipSuccess) fprintf(stderr, "cooperative launch failed: %s (grid %d)\n", hipGetErrorString(e), grid_blocks);
#endif
}
```

```cpp
#include <hip/hip_runtime.h>
#include <hip/hip_cooperative_groups.h>
#include <cstdio>
namespace cg = cooperative_groups;

#ifndef MULTI_LAUNCH
#define MULTI_LAUNCH 0
#endif
#define PROBE_DUP 0

#define LAS __attribute__((address_space(3)))
#define DI __device__ __forceinline__
typedef unsigned short bf16_t;
typedef short bf16x8 __attribute__((ext_vector_type(8)));
typedef float f32x4 __attribute__((ext_vector_type(4)));
typedef float f32x2 __attribute__((ext_vector_type(2)));
typedef unsigned u32x4 __attribute__((ext_vector_type(4)));
typedef unsigned u32x2 __attribute__((ext_vector_type(2)));

constexpr int T_ = 32768, D_ = 1024, S_ = 4096, FF_ = 2816, INC_ = 2560;
constexpr float EPS_ = 1e-6f;
constexpr float LOG2E = 1.4426950408889634f;

constexpr size_t MiB = 1024 * 1024;
constexpr size_t WS_WIN = 0;
constexpr size_t WS_WOUT = WS_WIN + 10 * MiB;
constexpr size_t WS_WF = WS_WOUT + 4 * MiB;
constexpr size_t WS_WGU = WS_WF + 4 * MiB;
constexpr size_t WS_WD = WS_WGU + 44 * MiB;
constexpr size_t WS_WLRU = WS_WD + 22 * MiB;
constexpr size_t WS_WDFT = WS_WLRU + 2 * MiB;
constexpr size_t WS_MISC = WS_WDFT + MiB / 4;
constexpr size_t WS_A = WS_MISC + 4 * MiB;
constexpr size_t WS_B = WS_A + 64 * MiB;
constexpr size_t WS_GY = WS_B + 128 * MiB;
constexpr size_t WS_E = WS_GY + 32 * MiB;
constexpr size_t WS_CS = WS_E + 176 * MiB;
constexpr size_t WS_END = WS_CS + 16 * MiB;
constexpr size_t MI_NLS = 0;
constexpr size_t MI_LAM = 8192;
constexpr size_t MI_KMAX = 8192 + 64;
constexpr size_t MI_AGG = 16384;
constexpr size_t MI_BAR = 16384 + 2 * 1024 * 1024;
constexpr size_t BAR_BYTES = 3456 * 4;
constexpr size_t MI_Y2048 = MI_BAR + 16384;
constexpr size_t MI_ALT = MI_Y2048 + 32768;
constexpr size_t MI_H2048 = MI_ALT + 65536;

constexpr int ATT_RING = 3 * 45056;
constexpr int LDS_BARW = ATT_RING;
constexpr int LDS_MBW = ATT_RING + 64;
constexpr int LDS_TOTAL = ATT_RING + 128;
struct Params { const float* in[23]; float* out; unsigned char* ws; int ph_lo, ph_hi; unsigned char tab[80]; };

DI unsigned cvt_pk_bf16(float lo, float hi) { unsigned r; asm("v_cvt_pk_bf16_f32 %0, %1, %2" : "=v"(r) : "v"(lo), "v"(hi)); return r; }
DI unsigned cvt_pk_nv(float lo, float hi) { unsigned r; asm("v_cvt_pk_bf16_f32 %0, %1, %2" : "=v"(r) : "v"(lo), "v"(hi)); return r; }
DI int lane_id_asm() { int l; asm volatile("v_mbcnt_lo_u32_b32 %0, -1, 0\n\tv_mbcnt_hi_u32_b32 %0, -1, %0" : "=v"(l)); return l; }
DI float bf2f(unsigned short b) { return __uint_as_float(((unsigned)b) << 16); }
DI float bflo(unsigned w) { return __uint_as_float(w << 16); }
DI float bfhi(unsigned w) { return __uint_as_float(w & 0xffff0000u); }
DI float sigmoidf_(float x) { return __builtin_amdgcn_rcpf(1.0f + __builtin_amdgcn_exp2f(-LOG2E * x)); }
DI float gelu_tanh(float y) { const float u = 1.5957691216057308f * (y + 0.044715f * y * y * y); return y * sigmoidf_(u); }
#define dpp_f(v, ctrl) __builtin_bit_cast(float, __builtin_amdgcn_update_dpp(0, __builtin_bit_cast(int, (v)), (ctrl), 0xf, 0xf, false))
DI float wave_sum(float v) {
    v += dpp_f(v, 0xB1); v += dpp_f(v, 0x4E); v += dpp_f(v, 0x141); v += dpp_f(v, 0x140);
    v += __shfl_xor(v, 16); v += __shfl_xor(v, 32); return v; }

namespace pg8 {
constexpr int BM = 256, BK = 64, HALF = 128, HTB = HALF * BK * 2, STAGE_BYTES = 8 * HTB, NXCD = 8, WGM = 8;
DI int lds_byte(int r, int c) { const int st = (r >> 4) * 2 + (c >> 5), rr = r & 15, cc = c & 31, ob = rr * 64 + cc * 2; return st * 1024 + (ob ^ (((ob >> 9) & 1) << 5)); }
DI void stage_rc(int b, int& R, int& C) { const int st = b / 1024, sb = b % 1024, swz = sb ^ (((sb >> 9) & 1) << 5); R = (st >> 1) * 16 + swz / 64; C = (st & 1) * 32 + (swz % 64) / 2; }
DI int perm32(int rho) { const int n = rho >> 4, i = rho & 15; return 8 * (i >> 2) + 4 * n + (i & 3); }

struct Unit { int pm, pn, z; };
struct Gemm { const bf16_t* A; const bf16_t* Bt; int lda, ldb, K, nM, nN, nZ; long sAz, sBz; int zdiv = 1 << 30; long sAhi = 0, sBhi = 0; const bf16_t* A2 = nullptr; int swapN = 1 << 30; };

struct Sched {
    int nM, nN, nwg, total, G, c;
    DI void init(int nM_, int nN_, int nZ_, int G_, int c_) { nM = nM_; nN = nN_; nwg = nM * nN; total = nwg * nZ_; G = G_; c = c_; }
    DI bool next(int i, Unit& u) const {
        const long L = (long)i * G + c; if (L >= total) return false;
        const int z = (int)(L / nwg); int wgid = (int)(L - (long)z * nwg);
        { const int q = nwg / NXCD, r = nwg % NXCD, xcd = wgid % NXCD, off = wgid / NXCD; wgid = (xcd < r ? xcd * (q + 1) : r * (q + 1) + (xcd - r) * q) + off; }
        const int nig = WGM * nN, gid = wgid / nig, fm = gid * WGM, gsz = (nM - fm) < WGM ? (nM - fm) : WGM;
        u.pm = fm + ((wgid % nig) % gsz); u.pn = (wgid % nig) / gsz; u.z = z; return true;
    }
};

template <class Epi>
DI void gemm_phase(LAS unsigned char* lds, const Gemm g, const Epi& E, const int tid) {
    const int wid = __builtin_amdgcn_readfirstlane(tid >> 6), lane = tid & 63, wr = wid >> 2, wc = wid & 3, fr = lane & 15, fq = lane >> 4;
    const int K = g.K, nt = K / BK;
    int bid_ = (int)blockIdx.x; asm volatile("" : "+s"(bid_));
    Sched S; S.init(g.nM, g.nN, g.nZ, (int)gridDim.x, bid_);
    unsigned voffA[2], voffB[2];
#pragma unroll
    for (int i = 0; i < 2; ++i) { int R, C; stage_rc(tid * 16 + i * 8192, R, C); const int Rb = Epi::PERM ? ((R & ~31) + perm32(R & 31)) : R;
        voffA[i] = (unsigned)(R * g.lda + C) * 2u; voffB[i] = (unsigned)(Rb * g.ldb + C) * 2u; }
    const size_t kstep = (size_t)(BK * 2);
    const size_t hstepA = (size_t)HALF * g.lda * 2, hstepB = (size_t)HALF * g.ldb * 2;
    const unsigned ldsw = (unsigned)wid * 1024u;
    const int aoff = lds_byte(wr * 64 + fr, fq * 8), boff = lds_byte(wc * 32 + fr, fq * 8);
#define PG8_APTR(u) ((u).pn >= g.swapN ? (const char*)(g.A2 + (size_t)((u).pn - g.swapN) * 256 * g.lda) : (const char*)(g.A + (size_t)((u).z % g.zdiv) * g.sAz + (size_t)((u).z / g.zdiv) * g.sAhi + (size_t)(u).pm * 256 * g.lda))
#define PG8_BPTR(u) ((u).pn >= g.swapN ? (const char*)(g.A + (size_t)(u).pm * 256 * g.lda) : (const char*)(g.Bt + (size_t)((u).z % g.zdiv) * g.sBz + (size_t)((u).z / g.zdiv) * g.sBhi + (size_t)(u).pn * 256 * g.ldb))
#define PG8_SA(b, h) (((b) * 2 + (h)) * HTB)
#define PG8_SB(b, h) ((4 + (b) * 2 + (h)) * HTB)
#define PG8_STAGE(bufoff, gbase, voff) do { _Pragma("unroll") for (int _i = 0; _i < 2; ++_i) \
        __builtin_amdgcn_global_load_lds((const unsigned*)((const char*)(gbase) + (voff)[_i]), (LAS unsigned*)(lds + (bufoff) + ldsw + _i * 8192), 16, 0, 0); } while (0)
#define PG8_LDA(dst, b, h) do { _Pragma("unroll") for (int m = 0; m < 4; ++m) _Pragma("unroll") for (int k = 0; k < 2; ++k) dst[m][k] = *(const LAS bf16x8*)(lds + PG8_SA(b, h) + aoff + m * 2048 + k * 1024); } while (0)
#define PG8_LDB(dst, b, h) do { _Pragma("unroll") for (int n = 0; n < 2; ++n) _Pragma("unroll") for (int k = 0; k < 2; ++k) dst[n][k] = *(const LAS bf16x8*)(lds + PG8_SB(b, h) + boff + n * 2048 + k * 1024); } while (0)
#define PG8_MMA(ai, bj, At, Bt) do { __builtin_amdgcn_s_setprio(1); _Pragma("unroll") for (int m = 0; m < 4; ++m) _Pragma("unroll") for (int n = 0; n < 2; ++n) _Pragma("unroll") for (int k = 0; k < 2; ++k) \
        acc[ai][bj][m][n] = __builtin_amdgcn_mfma_f32_16x16x32_bf16(Bt[n][k], At[m][k], acc[ai][bj][m][n], 0, 0, 0); __builtin_amdgcn_s_setprio(0); } while (0)
#define PG8_WAIT_V(n) asm volatile("s_waitcnt vmcnt(" #n ")" ::: "memory")
#define PG8_WAIT_L(n) asm volatile("s_waitcnt lgkmcnt(" #n ")" ::: "memory")
#define PG8_BAR __builtin_amdgcn_s_barrier()
#define PG8_SCHED __builtin_amdgcn_sched_barrier(0)
    Unit cur, nxt; int ui = 0;
    if (!S.next(0, cur)) return;
    f32x4 acc[2][2][4][2];
#pragma unroll
    for (int a = 0; a < 2; ++a)
#pragma unroll
        for (int b = 0; b < 2; ++b)
#pragma unroll
            for (int m = 0; m < 4; ++m)
#pragma unroll
                for (int n = 0; n < 2; ++n) acc[a][b][m][n] = (f32x4){0.f, 0.f, 0.f, 0.f};
    bf16x8 At[4][2], B0[2][2], B1[2][2];
    const char* cA = PG8_APTR(cur); const char* cB = PG8_BPTR(cur);
    PG8_STAGE(PG8_SB(0, 0), cB, voffB); PG8_STAGE(PG8_SA(0, 0), cA, voffA); PG8_STAGE(PG8_SB(0, 1), cB + hstepB, voffB); PG8_STAGE(PG8_SA(0, 1), cA + hstepA, voffA);
    if (wr == 1) PG8_BAR;
    PG8_WAIT_V(4); PG8_BAR;
    PG8_STAGE(PG8_SB(1, 0), cB + kstep, voffB); PG8_STAGE(PG8_SA(1, 0), cA + kstep, voffA); PG8_STAGE(PG8_SB(1, 1), cB + hstepB + kstep, voffB);
    PG8_WAIT_V(6); PG8_BAR;
    for (;;) {
        const bool has_next = S.next(ui + 1, nxt);
        const char* nA = has_next ? PG8_APTR(nxt) : cA; const char* nB = has_next ? PG8_BPTR(nxt) : cB;
        for (int t = 0; t < nt; t += 2) {
            const bool last = (t == nt - 2);
            const char* a1 = cA + (size_t)(t + 1) * kstep;
            const char* a2 = last ? nA : cA + (size_t)(t + 2) * kstep; const char* b2 = last ? nB : cB + (size_t)(t + 2) * kstep;
            const char* a3 = a2 + kstep; const char* b3 = b2 + kstep;
            PG8_LDB(B0, 0, 0); PG8_SCHED; PG8_LDA(At, 0, 0); PG8_STAGE(PG8_SA(1, 1), a1 + hstepA, voffA);
            PG8_WAIT_L(8); PG8_BAR; PG8_WAIT_L(0); PG8_MMA(0, 0, At, B0); PG8_BAR; PG8_SCHED;
            PG8_LDB(B1, 0, 1); PG8_STAGE(PG8_SB(0, 0), b2, voffB);
            PG8_BAR; PG8_WAIT_L(0); PG8_MMA(0, 1, At, B1); PG8_BAR;
            PG8_LDA(At, 0, 1); PG8_STAGE(PG8_SA(0, 0), a2, voffA);
            PG8_BAR; PG8_WAIT_L(0); PG8_MMA(1, 0, At, B0); PG8_BAR; PG8_SCHED;
            PG8_STAGE(PG8_SB(0, 1), b2 + hstepB, voffB);
            PG8_WAIT_V(6); PG8_BAR; PG8_MMA(1, 1, At, B1); PG8_BAR;
            PG8_LDB(B0, 1, 0); PG8_SCHED; PG8_LDA(At, 1, 0); PG8_STAGE(PG8_SA(0, 1), a2 + hstepA, voffA);
            PG8_WAIT_L(8); PG8_BAR; PG8_WAIT_L(0); PG8_MMA(0, 0, At, B0); PG8_BAR; PG8_SCHED;
            PG8_LDB(B1, 1, 1); PG8_STAGE(PG8_SB(1, 0), b3, voffB);
            PG8_BAR; PG8_WAIT_L(0); PG8_MMA(0, 1, At, B1); PG8_BAR;
            PG8_LDA(At, 1, 1); PG8_STAGE(PG8_SA(1, 0), a3, voffA);
            PG8_BAR; PG8_WAIT_L(0); PG8_MMA(1, 0, At, B0); PG8_BAR; PG8_SCHED;
            PG8_STAGE(PG8_SB(1, 1), b3 + hstepB, voffB);
            PG8_WAIT_V(6); PG8_BAR; PG8_MMA(1, 1, At, B1); PG8_BAR;
        }
        { const int lane_e = lane_id_asm();
          E(acc, cur, wr, wc, lane_e & 15, lane_e >> 4); }
        if (!has_next) break;
#pragma unroll
        for (int a = 0; a < 2; ++a)
#pragma unroll
            for (int b = 0; b < 2; ++b)
#pragma unroll
                for (int m = 0; m < 4; ++m)
#pragma unroll
                    for (int n = 0; n < 2; ++n) acc[a][b][m][n] = (f32x4){0.f, 0.f, 0.f, 0.f};
        cur = nxt; cA = nA; cB = nB; ++ui;
    }
    PG8_WAIT_V(0);
    if (wr == 0) PG8_BAR;
    PG8_BAR;
#undef PG8_APTR
#undef PG8_BPTR
#undef PG8_SA
#undef PG8_SB
#undef PG8_STAGE
#undef PG8_LDA
#undef PG8_LDB
#undef PG8_MMA
#undef PG8_WAIT_V
#undef PG8_WAIT_L
#undef PG8_BAR
#undef PG8_SCHED
}

struct EpiPlain {
    static constexpr bool PERM = true;
    bf16_t* O; int ldc; int zrows;
    DI void operator()(const f32x4 (&acc)[2][2][4][2], const Unit& u, int wr, int wc, int fr, int fq) const {
        const int row0 = u.z * zrows + u.pm * BM + wr * 64 + fr, col0 = u.pn * BM + wc * 32 + 8 * fq;
#pragma unroll
        for (int ai = 0; ai < 2; ++ai)
#pragma unroll
            for (int m = 0; m < 4; ++m) { bf16_t* rowp = O + (size_t)(row0 + ai * HALF + m * 16) * ldc + col0;
#pragma unroll
                for (int bj = 0; bj < 2; ++bj) { const f32x4 v0 = acc[ai][bj][m][0], v1 = acc[ai][bj][m][1];
                    u32x4 w; w.x = cvt_pk_bf16(v0[0], v0[1]); w.y = cvt_pk_bf16(v0[2], v0[3]); w.z = cvt_pk_bf16(v1[0], v1[1]); w.w = cvt_pk_bf16(v1[2], v1[3]);
                    *(u32x4*)(rowp + bj * HALF) = w; } }
    }
};
struct EpiSwiglu {
    static constexpr bool PERM = true;
    bf16_t* O;
    DI void operator()(const f32x4 (&acc)[2][2][4][2], const Unit& u, int wr, int wc, int fr, int fq) const {
        const int row0 = u.pm * BM + wr * 64 + fr, col0 = u.pn * HALF + wc * 32 + 8 * fq;
#pragma unroll
        for (int ai = 0; ai < 2; ++ai)
#pragma unroll
            for (int m = 0; m < 4; ++m) { bf16_t* rowp = O + (size_t)(row0 + ai * HALF + m * 16) * FF_ + col0;
                float ex[8], r[8];
#pragma unroll
                for (int i = 0; i < 8; ++i) ex[i] = __builtin_amdgcn_exp2f(-LOG2E * acc[ai][0][m][i >> 2][i & 3]);
#pragma unroll
                for (int i = 0; i < 8; ++i) ex[i] = __builtin_amdgcn_rcpf(1.0f + ex[i]);
#pragma unroll
                for (int i = 0; i < 8; ++i) r[i] = acc[ai][0][m][i >> 2][i & 3] * ex[i] * acc[ai][1][m][i >> 2][i & 3];
                u32x4 w; w.x = cvt_pk_nv(r[0], r[1]); w.y = cvt_pk_nv(r[2], r[3]); w.z = cvt_pk_nv(r[4], r[5]); w.w = cvt_pk_nv(r[6], r[7]);
                *(u32x4*)rowp = w; }
    }
};
struct EpiG1 {
    static constexpr bool PERM = true;
    bf16_t *q, *k, *vt, *xr, *gy;
    DI void operator()(const f32x4 (&acc)[2][2][4][2], const Unit& u, int wr, int wc, int fr, int fq) const {
        const int row0 = u.pm * BM + wr * 64 + fr;
        if (u.pn >= 8) {
            const int r0 = (u.pn - 8) * BM + wr * 64 + fr, t0 = u.pm * BM + wc * 32 + 8 * fq;
#pragma unroll
            for (int ai = 0; ai < 2; ++ai)
#pragma unroll
                for (int m = 0; m < 4; ++m) { const int vrow = r0 + ai * HALF + m * 16;
#pragma unroll
                    for (int bj = 0; bj < 2; ++bj) { const int t = t0 + bj * HALF; const int b = t >> 12, sq = t & 4095;
                        const f32x4 v0 = acc[ai][bj][m][0], v1 = acc[ai][bj][m][1];
                        u32x4 w; w.x = cvt_pk_bf16(v0[0], v0[1]); w.y = cvt_pk_bf16(v0[2], v0[3]); w.z = cvt_pk_bf16(v1[0], v1[1]); w.w = cvt_pk_bf16(v1[2], v1[3]);
                        *(u32x4*)(vt + ((size_t)(b * 512 + vrow)) * S_ + sq) = w; } }
            return;
        }
        const int sec = u.pn >> 1;
        const int colb = (u.pn & 1) * BM + wc * 32 + 8 * fq;
        bf16_t* base = sec == 0 ? q : (sec == 1 ? k : (sec == 2 ? xr : gy));
        const float sc = sec == 0 ? (0.125f * LOG2E) : 1.0f;
#pragma unroll
        for (int ai = 0; ai < 2; ++ai)
#pragma unroll
            for (int m = 0; m < 4; ++m) { bf16_t* rowp = base + (size_t)(row0 + ai * HALF + m * 16) * 512 + colb;
#pragma unroll
                for (int bj = 0; bj < 2; ++bj) { f32x4 v0 = acc[ai][bj][m][0] * sc, v1 = acc[ai][bj][m][1] * sc;
                    if (sec == 3) {
                        float ge[8];
#pragma unroll
                        for (int j = 0; j < 8; ++j) { const float y = j < 4 ? v0[j & 3] : v1[j & 3]; ge[j] = __builtin_amdgcn_exp2f(-LOG2E * 1.5957691216057308f * (y + 0.044715f * y * y * y)); }
#pragma unroll
                        for (int j = 0; j < 8; ++j) ge[j] = __builtin_amdgcn_rcpf(1.0f + ge[j]);
#pragma unroll
                        for (int j = 0; j < 4; ++j) { v0[j] *= ge[j]; v1[j] *= ge[4 + j]; } }
                    u32x4 w; w.x = cvt_pk_bf16(v0[0], v0[1]); w.y = cvt_pk_bf16(v0[2], v0[3]); w.z = cvt_pk_bf16(v1[0], v1[1]); w.w = cvt_pk_bf16(v1[2], v1[3]);
                    *(u32x4*)(rowp + bj * HALF) = w; } }
    }
};
struct EpiGates {
    static constexpr bool PERM = false;
    const bf16_t* xc; const float* ba; const float* bi; const float* nls; unsigned* au;
    DI void operator()(const f32x4 (&acc)[2][2][4][2], const Unit& u, int wr, int wc, int fr, int fq) const {
        const int row0 = u.pm * BM + wr * 64 + fr, dir = u.pn;
#pragma unroll
        for (int n = 0; n < 2; ++n) {
            const int c = u.z * 128 + wc * 32 + 16 * n + 4 * fq;
            const f32x4 bav = *(const f32x4*)(ba + dir * 512 + c), biv = *(const f32x4*)(bi + dir * 512 + c), nl = *(const f32x4*)(nls + dir * 512 + c);
#pragma unroll
            for (int ai = 0; ai < 2; ++ai)
#pragma unroll
                for (int m = 0; m < 4; ++m) { const int row = row0 + ai * HALF + m * 16;
                    const u32x2 xw = *(const u32x2*)(xc + (size_t)row * 512 + c);
                    const float xv[4] = {bflo(xw.x), bfhi(xw.x), bflo(xw.y), bfhi(xw.y)};
                    u32x4 w; float e1[4], e2[4], la[4], sq[4];
#pragma unroll
                    for (int j = 0; j < 4; ++j) { e1[j] = __builtin_amdgcn_exp2f(-LOG2E * (acc[ai][0][m][n][j] + bav[j])); e2[j] = __builtin_amdgcn_exp2f(-LOG2E * (acc[ai][1][m][n][j] + biv[j])); }
#pragma unroll
                    for (int j = 0; j < 4; ++j) { e1[j] = __builtin_amdgcn_rcpf(1.0f + e1[j]); e2[j] = __builtin_amdgcn_rcpf(1.0f + e2[j]); }
#pragma unroll
                    for (int j = 0; j < 4; ++j) { la[j] = e1[j] * nl[j]; sq[j] = __builtin_amdgcn_exp2f(2.0f * la[j]); }
#pragma unroll
                    for (int j = 0; j < 4; ++j) sq[j] = __builtin_amdgcn_sqrtf(fmaxf(1.0f - sq[j], 0.f));
#pragma unroll
                    for (int j = 0; j < 4; ++j) w[j] = cvt_pk_nv(la[j], sq[j] * e2[j] * xv[j]);
                    *(u32x4*)(au + ((size_t)dir * T_ + row) * 512 + c) = w; }
        }
    }
};
struct EpiDftC {
    static constexpr bool PERM = true;
    bf16_t* Yt;
    DI void operator()(const f32x4 (&acc)[2][2][4][2], const Unit& u, int wr, int wc, int fr, int fq) const {
        const int nl0 = wr * 64 + fr, t0 = u.pn * BM + wc * 32 + 8 * fq;
#pragma unroll
        for (int ai = 0; ai < 2; ++ai)
#pragma unroll
            for (int m = 0; m < 4; ++m) { const int nl = nl0 + ai * HALF + m * 16;
#pragma unroll
                for (int bj = 0; bj < 2; ++bj) { const int t = t0 + bj * HALF; const int b = t >> 12, s = t & 4095;
                    const f32x4 v0 = acc[ai][bj][m][0], v1 = acc[ai][bj][m][1];
                    u32x4 w; w.x = cvt_pk_bf16(v0[0], v0[1]); w.y = cvt_pk_bf16(v0[2], v0[3]); w.z = cvt_pk_bf16(v1[0], v1[1]); w.w = cvt_pk_bf16(v1[2], v1[3]);
                    *(u32x4*)(Yt + (((size_t)(b * 1024 + u.z * 256 + nl)) * 2 + u.pm) * S_ + s) = w; } }
    }
};


struct EpiDftC2 {
    static constexpr bool PERM = true;
    bf16_t* Ye;
    DI void operator()(const f32x4 (&acc)[2][2][4][2], const Unit& u, int wr, int wc, int fr, int fq) const {
        const int nl0 = wr * 64 + fr, t0 = u.pn * BM + wc * 32 + 8 * fq, part = u.z >> 2, gq = u.z & 3;
#pragma unroll
        for (int ai = 0; ai < 2; ++ai)
#pragma unroll
            for (int m = 0; m < 4; ++m) { const int nl = nl0 + ai * HALF + m * 16;
#pragma unroll
                for (int bj = 0; bj < 2; ++bj) { const int t = t0 + bj * HALF; const int b = t >> 11, sq = t & 2047;
                    const f32x4 v0 = acc[ai][bj][m][0], v1 = acc[ai][bj][m][1];
                    u32x4 w; w.x = cvt_pk_bf16(v0[0], v0[1]); w.y = cvt_pk_bf16(v0[2], v0[3]); w.z = cvt_pk_bf16(v1[0], v1[1]); w.w = cvt_pk_bf16(v1[2], v1[3]);
                    *(u32x4*)(Ye + (((size_t)(b * 1024 + gq * 256 + nl)) * 2 + part) * 2048 + sq) = w; } }
    }
};

struct EpiF32 {
    static constexpr bool PERM = false;
    float* C; int ldc; int zrows;
    DI void operator()(const f32x4 (&acc)[2][2][4][2], const Unit& u, int wr, int wc, int fr, int fq) const {
        const int row0 = u.z * zrows + u.pm * BM + wr * 64 + fr, col0 = u.pn * BM + wc * 32 + 4 * fq;
#pragma unroll
        for (int ai = 0; ai < 2; ++ai)
#pragma unroll
            for (int m = 0; m < 4; ++m) { float* rowp = C + (size_t)(row0 + ai * HALF + m * 16) * ldc + col0;
#pragma unroll
                for (int bj = 0; bj < 2; ++bj)
#pragma unroll
                    for (int n = 0; n < 2; ++n) *(f32x4*)(rowp + bj * HALF + n * 16) = acc[ai][bj][m][n]; }
    }
};
struct EpiDftQ {
    static constexpr bool PERM = false;
    const float* Pm; const float* y2048; bf16_t* F;
    DI void operator()(const f32x4 (&acc)[2][2][4][2], const Unit& u, int wr, int wc, int fr, int fq) const {
        const int k0 = u.pm * BM + wr * 64 + fr, col0 = u.pn * BM + wc * 32 + 4 * fq, b = u.z;
#pragma unroll
        for (int bj = 0; bj < 2; ++bj)
#pragma unroll
            for (int n = 0; n < 2; ++n) { const int c = col0 + bj * HALF + n * 16;
                const f32x4 yv = *(const f32x4*)(y2048 + b * 1024 + c) * (1.0f / 64.0f);
#pragma unroll
                for (int ai = 0; ai < 2; ++ai)
#pragma unroll
                    for (int m = 0; m < 4; ++m) { const int k = k0 + ai * HALF + m * 16;
                        const f32x4 pv = __builtin_nontemporal_load((const f32x4*)(Pm + ((size_t)(b * 2048 + k)) * 1024 + c)) + ((k & 1) ? -yv : yv);
                        const f32x4 q = acc[ai][bj][m][n]; const f32x4 f1 = pv - q, f2 = pv + q;
                        u32x2 w1; w1.x = cvt_pk_bf16(f1[0], f1[1]); w1.y = cvt_pk_bf16(f1[2], f1[3]);
                        *(u32x2*)(F + ((size_t)(b * 4096 + k)) * 1024 + c) = w1;
                        if (k) { u32x2 w2; w2.x = cvt_pk_bf16(f2[0], f2[1]); w2.y = cvt_pk_bf16(f2[2], f2[3]); *(u32x2*)(F + ((size_t)(b * 4096 + 4096 - k)) * 1024 + c) = w2; }
                        asm volatile("" ::: "memory"); }
            }
    }
};

struct EpiDftPQ {
    static constexpr bool PERM = false;
    float* Pm; const float* y2048; bf16_t* F;
    DI void operator()(const f32x4 (&acc)[2][2][4][2], const Unit& u, int wr, int wc, int fr, int fq) const {
        if (u.z < 8) { const EpiF32 e{Pm, D_, 2048}; e(acc, u, wr, wc, fr, fq); }
        else { Unit v = u; v.z = u.z - 8; const EpiDftQ e{Pm, y2048, F}; e(acc, v, wr, wc, fr, fq); }
    }
};
}


#define XB_TMO      128
#define XB_XCNT(j)  (256  + 64 * (j))
#define XB_XSUB(j)  (1280 + 64 * (j))
#define XB_XGEN(j)  (2304 + 64 * (j))
#define XB_TOP      3328
#define XB_TOPGEN   3392
#define XCD_BAR_WORDS 3456
#define XB_SPIN_CAP (1u << 20)
DI unsigned xb_ld(unsigned* p)              { return __hip_atomic_load(p, __ATOMIC_RELAXED, __HIP_MEMORY_SCOPE_AGENT); }
DI unsigned xb_add(unsigned* p, unsigned v) { return __hip_atomic_fetch_add(p, v, __ATOMIC_RELAXED, __HIP_MEMORY_SCOPE_AGENT); }
DI unsigned xb_xcc_id() { return (unsigned)__builtin_amdgcn_s_getreg((3 << 11) | 20) & 0xFu; }
#define XB_SPIN(cond, bar) do { unsigned _sp = 0; while (cond) { __builtin_amdgcn_s_sleep(1); \
    if ((++_sp & 255u) == 0u) { if (xb_ld(&(bar)[XB_TMO])) break; if (_sp > XB_SPIN_CAP) { atomicAdd(&(bar)[XB_TMO], 1u); break; } } } } while (0)
DI void xcd_barrier_complete(unsigned* bar, unsigned x, unsigned& nloc, unsigned& nx) {
    const unsigned G = gridDim.x;
    unsigned sum, cnt, mine, sp = 0u;
    for (;;) {
        sum = 0u; cnt = 0u; mine = 0u;
#pragma unroll
        for (unsigned j = 0; j < 16; ++j) { const unsigned c = xb_ld(&bar[XB_XCNT(j)]); sum += c; cnt += (c > 0u) ? 1u : 0u; mine = (j == x) ? c : mine; }
        if (sum == G) break;
        __builtin_amdgcn_s_sleep(1);
        if ((++sp & 255u) == 0u) { if (xb_ld(&bar[XB_TMO])) break; if (sp > XB_SPIN_CAP) { atomicAdd(&bar[XB_TMO], 1u); break; } }
    }
    nloc = mine > 0u ? mine : 1u; nx = cnt > 0u ? cnt : 1u;
}
DI void xcd_barrier(unsigned* bar, volatile LAS unsigned* st, bool leader) {
    asm volatile("s_waitcnt vmcnt(0)" ::: "memory");
    __syncthreads();
    if (leader) {
        const unsigned x = xb_xcc_id();
        __builtin_amdgcn_s_waitcnt(0);
        unsigned nloc = st[0], nx = st[1];
        if (nloc == 0u) { xcd_barrier_complete(bar, x, nloc, nx); st[0] = nloc; st[1] = nx; }
        const unsigned old = xb_add(&bar[XB_XSUB(x)], 1u);
        const unsigned gen = old / nloc;
        if (old + 1u == (gen + 1u) * nloc) {
            __builtin_amdgcn_fence(__ATOMIC_RELEASE, "agent");
            asm volatile("s_waitcnt vmcnt(0)" ::: "memory");
            const unsigned og = xb_add(&bar[XB_TOP], 1u);
            const unsigned tg = og / nx;
            if (og + 1u == (tg + 1u) * nx) xb_add(&bar[XB_TOPGEN], 1u);
            else XB_SPIN(xb_ld(&bar[XB_TOPGEN]) == tg, bar);
            __builtin_amdgcn_fence(__ATOMIC_ACQUIRE, "agent");
            xb_add(&bar[XB_XGEN(x)], 1u);
            asm volatile("s_waitcnt vmcnt(0)" ::: "memory");
        } else {
            XB_SPIN(xb_ld(&bar[XB_XGEN(x)]) == gen, bar);
            __builtin_amdgcn_fence(__ATOMIC_ACQUIRE, "agent");
            asm volatile("s_waitcnt vmcnt(0)" ::: "memory");
        }
    }
    __syncthreads();
}

DI void transpose_cvt(const int tid, LAS float* tl, const float* src, int K, int N, bf16_t* dst, int ldd, int mode) {
    const int tk = K / 64, tn = N / 64;
    for (int tile = blockIdx.x; tile < tk * tn; tile += gridDim.x) {
        const int k0 = (tile / tn) * 64, n0 = (tile % tn) * 64;
        __syncthreads();
#pragma unroll
        for (int i = 0; i < 8; ++i) { const int kk = (tid >> 6) + 8 * i, nn = tid & 63; tl[kk * 65 + nn] = __builtin_nontemporal_load(src + (size_t)(k0 + kk) * N + n0 + nn); }
        __syncthreads();
        const int nl = tid >> 3, kc = tid & 7; float v[8];
#pragma unroll
        for (int j = 0; j < 8; ++j) v[j] = tl[(kc * 8 + j) * 65 + nl];
        const int n = n0 + nl; const int drow = mode == 0 ? n : (mode == 3 ? (n < 1024 ? n : (n < 1536 ? n + 1024 : n - 512)) : ((n >> 7) * 256 + (n & 127) + (mode == 2 ? 128 : 0)));
        u32x4 w; w.x = cvt_pk_bf16(v[0], v[1]); w.y = cvt_pk_bf16(v[2], v[3]); w.z = cvt_pk_bf16(v[4], v[5]); w.w = cvt_pk_bf16(v[6], v[7]);
        *(u32x4*)(dst + (size_t)drow * ldd + k0 + kc * 8) = w;
    }
}

DI void rowpass(const int tid, const float* xin, float* xout, const bf16_t* m, const float* gpost, const float* gnext, bf16_t* hn, const bf16_t* m2 = nullptr, const float* gpost2 = nullptr) {
    const int lane = tid & 63, wid = tid >> 6;
    const int stride = gridDim.x * 16;
    int row0 = (blockIdx.x * 8 + wid) * 2;
    f32x4 x[2][4]; u32x2 mw[2][4], mw2[2][4];
#define ROW_LOAD(X, M, M2, R0) do { _Pragma("unroll") for (int r = 0; r < 2; ++r) _Pragma("unroll") for (int i = 0; i < 4; ++i) { \
        X[r][i] = __builtin_nontemporal_load((const f32x4*)(xin + (size_t)((R0) + r) * D_ + i * 256 + lane * 4)); \
        if (m) M[r][i] = __builtin_nontemporal_load((const u32x2*)(m + (size_t)((R0) + r) * D_ + i * 256 + lane * 4)); \
        if (m2) M2[r][i] = __builtin_nontemporal_load((const u32x2*)(m2 + (size_t)((R0) + r) * D_ + i * 256 + lane * 4)); } } while (0)
    if (row0 < T_) ROW_LOAD(x, mw, mw2, row0);
    for (; row0 < T_; row0 += stride) {
        f32x4 xn[2][4]; u32x2 mn[2][4], mn2[2][4];
        const int nrow = row0 + stride;
        if (nrow < T_) ROW_LOAD(xn, mn, mn2, nrow);
        if (m) {
#pragma unroll
            for (int r = 0; r < 2; ++r) {
                f32x4 mv[4]; float ss = 0.f;
#pragma unroll
                for (int i = 0; i < 4; ++i) { const u32x2 w = mw[r][i];
                    mv[i] = (f32x4){bflo(w.x), bfhi(w.x), bflo(w.y), bfhi(w.y)}; ss += mv[i][0] * mv[i][0] + mv[i][1] * mv[i][1] + mv[i][2] * mv[i][2] + mv[i][3] * mv[i][3]; }
                ss = wave_sum(ss); const float rr = __builtin_amdgcn_rsqf(ss * (1.0f / D_) + EPS_);
#pragma unroll
                for (int i = 0; i < 4; ++i) { const f32x4 gp = *(const f32x4*)(gpost + i * 256 + lane * 4); x[r][i] += mv[i] * rr * gp; }
                if (m2) {
                    float s2 = 0.f;
#pragma unroll
                    for (int i = 0; i < 4; ++i) { const u32x2 w = mw2[r][i];
                        mv[i] = (f32x4){bflo(w.x), bfhi(w.x), bflo(w.y), bfhi(w.y)}; s2 += mv[i][0] * mv[i][0] + mv[i][1] * mv[i][1] + mv[i][2] * mv[i][2] + mv[i][3] * mv[i][3]; }
                    s2 = wave_sum(s2); const float r2 = __builtin_amdgcn_rsqf(s2 * (1.0f / D_) + EPS_);
#pragma unroll
                    for (int i = 0; i < 4; ++i) { const f32x4 gp = *(const f32x4*)(gpost2 + i * 256 + lane * 4); x[r][i] += mv[i] * r2 * gp; }
                }
                if (xout) {
#pragma unroll
                    for (int i = 0; i < 4; ++i) __builtin_nontemporal_store(x[r][i], (f32x4*)(xout + (size_t)(row0 + r) * D_ + i * 256 + lane * 4)); }
            }
        }
        if (hn) {
#pragma unroll
            for (int r = 0; r < 2; ++r) {
                float ss = 0.f;
#pragma unroll
                for (int i = 0; i < 4; ++i) ss += x[r][i][0] * x[r][i][0] + x[r][i][1] * x[r][i][1] + x[r][i][2] * x[r][i][2] + x[r][i][3] * x[r][i][3];
                ss = wave_sum(ss); const float rr = __builtin_amdgcn_rsqf(ss * (1.0f / D_) + EPS_);
#pragma unroll
                for (int i = 0; i < 4; ++i) { const f32x4 gn = *(const f32x4*)(gnext + i * 256 + lane * 4); const f32x4 y = x[r][i] * rr * gn;
                    u32x2 w; w.x = cvt_pk_bf16(y[0], y[1]); w.y = cvt_pk_bf16(y[2], y[3]); *(u32x2*)(hn + (size_t)(row0 + r) * D_ + i * 256 + lane * 4) = w; }
            }
        }
#pragma unroll
        for (int r = 0; r < 2; ++r)
#pragma unroll
            for (int i = 0; i < 4; ++i) { x[r][i] = xn[r][i]; mw[r][i] = mn[r][i]; mw2[r][i] = mn2[r][i]; }
    }
#undef ROW_LOAD
}

DI void rowpass_fold(const int tid, const float* xin, float* xout, const bf16_t* m, const float* gpost, const bf16_t* m2, const float* gpost2, const float* gnext, bf16_t* He, bf16_t* Ho, float* alt, float* h2048) {
    const int lane = tid & 63, wid = tid >> 6;
    const int nW = gridDim.x * 8;
    f32x4 x[2][4]; u32x2 mw[2][4], mw2[2][4];
#define FOLD_ROWS(IDX, B, SQ, RA, RB) const int B = ((IDX) & 2047) >> 8, SQ = ((IDX) & 255) + 256 * ((IDX) >> 11); const int RA = B * S_ + SQ, RB = B * S_ + (SQ ? S_ - SQ : 2048)
#define FOLD_LOAD(X, M, M2, RA, RB) do { _Pragma("unroll") for (int i = 0; i < 4; ++i) { \
        X[0][i] = __builtin_nontemporal_load((const f32x4*)(xin + (size_t)(RA) * D_ + i * 256 + lane * 4)); X[1][i] = __builtin_nontemporal_load((const f32x4*)(xin + (size_t)(RB) * D_ + i * 256 + lane * 4)); \
        M[0][i] = __builtin_nontemporal_load((const u32x2*)(m + (size_t)(RA) * D_ + i * 256 + lane * 4)); M[1][i] = __builtin_nontemporal_load((const u32x2*)(m + (size_t)(RB) * D_ + i * 256 + lane * 4)); \
        M2[0][i] = __builtin_nontemporal_load((const u32x2*)(m2 + (size_t)(RA) * D_ + i * 256 + lane * 4)); M2[1][i] = __builtin_nontemporal_load((const u32x2*)(m2 + (size_t)(RB) * D_ + i * 256 + lane * 4)); } } while (0)
    int idx = blockIdx.x * 8 + wid;
    f32x4 al[4]; int curb = -1;
#pragma unroll
    for (int i = 0; i < 4; ++i) al[i] = (f32x4){0.f, 0.f, 0.f, 0.f};
    if (idx < 16384) { FOLD_ROWS(idx, b0_, s0_, ra0_, rb0_); (void)b0_; (void)s0_; FOLD_LOAD(x, mw, mw2, ra0_, rb0_); }
    for (; idx < 16384; idx += nW) {
        FOLD_ROWS(idx, b, sq, rA, rB);
        f32x4 xn[2][4]; u32x2 mn[2][4], mn2[2][4];
        const int nidx = idx + nW;
        if (nidx < 16384) { FOLD_ROWS(nidx, b1_, s1_, ra1_, rb1_); (void)b1_; (void)s1_; FOLD_LOAD(xn, mn, mn2, ra1_, rb1_); }
        if (b != curb) {
            if (curb >= 0) {
#pragma unroll
                for (int i = 0; i < 4; ++i)
#pragma unroll
                    for (int j = 0; j < 4; ++j) atomicAdd(alt + curb * 1024 + i * 256 + lane * 4 + j, al[i][j]); }
#pragma unroll
            for (int i = 0; i < 4; ++i) al[i] = (f32x4){0.f, 0.f, 0.f, 0.f};
            curb = b;
        }
        f32x4 hv[2][4];
#pragma unroll
        for (int r = 0; r < 2; ++r) { const int row = r ? rB : rA;
            f32x4 mv[4]; float ss = 0.f;
#pragma unroll
            for (int i = 0; i < 4; ++i) { const u32x2 w = mw[r][i];
                mv[i] = (f32x4){bflo(w.x), bfhi(w.x), bflo(w.y), bfhi(w.y)}; ss += mv[i][0] * mv[i][0] + mv[i][1] * mv[i][1] + mv[i][2] * mv[i][2] + mv[i][3] * mv[i][3]; }
            ss = wave_sum(ss); const float rr = __builtin_amdgcn_rsqf(ss * (1.0f / D_) + EPS_);
#pragma unroll
            for (int i = 0; i < 4; ++i) { const f32x4 gp = *(const f32x4*)(gpost + i * 256 + lane * 4); x[r][i] += mv[i] * rr * gp; }
            float sb = 0.f;
#pragma unroll
            for (int i = 0; i < 4; ++i) { const u32x2 w = mw2[r][i];
                mv[i] = (f32x4){bflo(w.x), bfhi(w.x), bflo(w.y), bfhi(w.y)}; sb += mv[i][0] * mv[i][0] + mv[i][1] * mv[i][1] + mv[i][2] * mv[i][2] + mv[i][3] * mv[i][3]; }
            sb = wave_sum(sb); const float rb = __builtin_amdgcn_rsqf(sb * (1.0f / D_) + EPS_);
            float s2 = 0.f;
#pragma unroll
            for (int i = 0; i < 4; ++i) { const f32x4 gp = *(const f32x4*)(gpost2 + i * 256 + lane * 4); x[r][i] += mv[i] * rb * gp; __builtin_nontemporal_store(x[r][i], (f32x4*)(xout + (size_t)row * D_ + i * 256 + lane * 4));
                s2 += x[r][i][0] * x[r][i][0] + x[r][i][1] * x[r][i][1] + x[r][i][2] * x[r][i][2] + x[r][i][3] * x[r][i][3]; }
            s2 = wave_sum(s2); const float r2 = __builtin_amdgcn_rsqf(s2 * (1.0f / D_) + EPS_);
#pragma unroll
            for (int i = 0; i < 4; ++i) { const f32x4 gn = *(const f32x4*)(gnext + i * 256 + lane * 4); hv[r][i] = x[r][i] * r2 * gn; }
        }
        const float sg = (sq & 1) ? -1.f : 1.f;
#pragma unroll
        for (int i = 0; i < 4; ++i) { const f32x4 he = sq ? hv[0][i] + hv[1][i] : hv[0][i]; const f32x4 ho = sq ? hv[0][i] - hv[1][i] : (f32x4){0.f, 0.f, 0.f, 0.f};
            al[i] += sq ? he * sg : hv[0][i] + hv[1][i];
            u32x2 w; w.x = cvt_pk_bf16(he[0], he[1]); w.y = cvt_pk_bf16(he[2], he[3]); *(u32x2*)(He + ((size_t)b * 2048 + sq) * D_ + i * 256 + lane * 4) = w;
            w.x = cvt_pk_bf16(ho[0], ho[1]); w.y = cvt_pk_bf16(ho[2], ho[3]); *(u32x2*)(Ho + ((size_t)b * 2048 + sq) * D_ + i * 256 + lane * 4) = w;
            if (sq == 0) *(f32x4*)(h2048 + b * 1024 + i * 256 + lane * 4) = hv[1][i]; }
#pragma unroll
        for (int r = 0; r < 2; ++r)
#pragma unroll
            for (int i = 0; i < 4; ++i) { x[r][i] = xn[r][i]; mw[r][i] = mn[r][i]; mw2[r][i] = mn2[r][i]; }
    }
    if (curb >= 0) {
#pragma unroll
        for (int i = 0; i < 4; ++i)
#pragma unroll
            for (int j = 0; j < 4; ++j) atomicAdd(alt + curb * 1024 + i * 256 + lane * 4 + j, al[i][j]); }
#undef FOLD_ROWS
#undef FOLD_LOAD
}

#define LANE_TID const int lane = lane_id_asm(); const int wid = wave_s; const int tid = wid * 64 + lane; (void)tid; (void)lane; (void)wid
enum { PH_PREP = 0, PH_G1, PH_CONV, PH_GATES, PH_ATTN, PH_SCAN2, PH_MIXOUT, PH_ROW1, PH_FFN1, PH_FFN2, PH_ROW2, PH_DFTC, PH_DFTS, PH_FOUT, PH_PRE, PH_DFTQ };
constexpr int N_PHASES = 1 + 10 + 7 + 10 + 7;

DI void decode_phase(int ph, int& type, int& layer) {
    if (ph == 0) { type = PH_PREP; layer = 0; return; }
    int p = ph - 1;
    if (p < 10) { layer = 0; type = PH_G1 + p; return; }
    p -= 10;
    if (p < 7) { layer = 1; type = p < 3 ? PH_DFTC + p : PH_ROW1 + (p - 3); return; }
    p -= 7;
    if (p < 10) { layer = 2; type = PH_G1 + p; return; }
    p -= 10;
    layer = 3; type = p < 3 ? PH_DFTC + p : PH_ROW1 + (p - 3);
}

__global__ void __launch_bounds__(512, 2) fwd_megakernel(Params Pk) {
    extern __shared__ __attribute__((aligned(16))) unsigned char shm[];
    LAS unsigned char* lds = (LAS unsigned char*)shm;
    cg::grid_group grid = cg::this_grid();
    const int ph_lo = Pk.ph_lo, ph_hi = Pk.ph_hi;
    const int wave_s = __builtin_amdgcn_readfirstlane((int)(threadIdx.x >> 6));
    if (threadIdx.x < 4) ((volatile LAS unsigned*)(lds + LDS_BARW))[threadIdx.x] = 0u;
    __syncthreads();
    if (threadIdx.x == 0) (void)xb_add(&((unsigned*)(Pk.ws + WS_MISC + MI_BAR))[XB_XCNT(xb_xcc_id())], 1u);
    for (int ph = ph_lo; ph < ph_hi; ++ph) {
        typedef const __attribute__((address_space(4))) Params* KP;
        KP pp = (KP)__builtin_amdgcn_kernarg_segment_ptr(); asm volatile("" : "+s"(pp));
        const __attribute__((address_space(4))) Params& P = *pp;
        unsigned char* ws = P.ws; asm volatile("" : "+s"(ws));
        bf16_t* WIN = (bf16_t*)(ws + WS_WIN); bf16_t* WOUT = (bf16_t*)(ws + WS_WOUT); bf16_t* WF = (bf16_t*)(ws + WS_WF);
        bf16_t* WGU = (bf16_t*)(ws + WS_WGU); bf16_t* WD = (bf16_t*)(ws + WS_WD); bf16_t* WLRU = (bf16_t*)(ws + WS_WLRU); bf16_t* WDFT = (bf16_t*)(ws + WS_WDFT);
        float* NLS = (float*)(ws + WS_MISC + MI_NLS); float* LAMV = (float*)(ws + WS_MISC + MI_LAM); unsigned* KMAX = (unsigned*)(ws + WS_MISC + MI_KMAX);
        f32x2* AGG = (f32x2*)(ws + WS_MISC + MI_AGG);
        bf16_t* HN = (bf16_t*)(ws + WS_A); bf16_t* CAT = HN;
        bf16_t* QB = (bf16_t*)(ws + WS_B); bf16_t* KB = QB + (size_t)T_ * 512; bf16_t* VT = KB + (size_t)T_ * 512; bf16_t* XR = VT + (size_t)T_ * 512;
        float* HF = (float*)(ws + WS_B); bf16_t* FB = (bf16_t*)(ws + WS_B);
        bf16_t* DM = (bf16_t*)(ws + WS_B + 64 * MiB); bf16_t* MB = DM;
        bf16_t* GY = (bf16_t*)(ws + WS_GY);
        bf16_t* CSM = (bf16_t*)(ws + WS_CS); float* Y2048 = (float*)(ws + WS_MISC + MI_Y2048); bf16_t* YE = (bf16_t*)(ws + WS_E + 64 * MiB); bf16_t* HE = (bf16_t*)(ws + WS_E); bf16_t* HO = (bf16_t*)(ws + WS_E + 32 * MiB); float* ALT0 = (float*)(ws + WS_MISC + MI_ALT); float* H2048 = (float*)(ws + WS_MISC + MI_H2048); float* PM = (float*)(ws + WS_B + 64 * MiB);
        unsigned* AU = (unsigned*)(ws + WS_E); bf16_t* XC = (bf16_t*)(ws + WS_E + 128 * MiB); bf16_t* ACT = (bf16_t*)(ws + WS_E); bf16_t* YT = (bf16_t*)(ws + WS_E);

        const int code_ = P.tab[ph]; const int type = code_ & 15, l = (code_ >> 4) & 3, pflag = code_ >> 6;
        const int e = l >> 1;
        float* ALT = ALT0 + e * 8192;
#ifdef ONLY_PHASE
        if (type != ONLY_PHASE) continue;
#endif
        switch (type) {
        case PH_PREP: { LANE_TID;
            LAS float* tl = (LAS float*)lds;
            for (int ee = 0; ee < 2; ++ee) {
                transpose_cvt(tid, tl, P.in[5] + (size_t)ee * D_ * INC_, D_, INC_, WIN + (size_t)ee * INC_ * D_, D_, 3);
                transpose_cvt(tid, tl, P.in[6] + (size_t)ee * D_ * D_, D_, D_, WOUT + (size_t)ee * D_ * D_, D_, 0);
                transpose_cvt(tid, tl, P.in[19] + (size_t)ee * D_ * D_, D_, D_, WF + (size_t)ee * D_ * D_, D_, 0);
            }
            for (int ll = 0; ll < 4; ++ll) {
                transpose_cvt(tid, tl, P.in[20] + (size_t)ll * D_ * FF_, D_, FF_, WGU + (size_t)ll * 2 * FF_ * D_, D_, 1);
                transpose_cvt(tid, tl, P.in[21] + (size_t)ll * D_ * FF_, D_, FF_, WGU + (size_t)ll * 2 * FF_ * D_, D_, 2);
                transpose_cvt(tid, tl, P.in[22] + (size_t)ll * FF_ * D_, FF_, D_, WD + (size_t)ll * D_ * FF_, FF_, 0);
            }
            const int gtid = blockIdx.x * 512 + tid, gn = gridDim.x * 512;
            for (int idx = gtid; idx < 2 * 4 * 512 * 256; idx += gn) {
                const int k = idx & 255, row = (idx >> 8) & 511, h = (idx >> 17) & 3, ee = idx >> 19;
                const int dir = row >> 8, gate = (row >> 7) & 1, j = row & 127;
                float v = 0.f;
                if (k < 128) v = (gate ? P.in[16] : P.in[14])[((size_t)((ee * 2 + dir) * 4 + h) * 128 + k) * 128 + j];
                WLRU[idx] = (bf16_t)(cvt_pk_bf16(v, 0.f) & 0xffffu);
            }
            for (int idx = gtid; idx < 512 * 256; idx += gn) {
                const int c = idx & 255, n = (idx >> 8) & 255, part = idx >> 16;
                const float ang = (float)((n * c) & 255) * (1.0f / 128.0f); float sv, cv; sincospif(ang, &sv, &cv);
                WDFT[idx] = (bf16_t)(cvt_pk_bf16((part ? sv : cv) * 0.0625f, 0.f) & 0xffffu);
            }
            for (int idx = gtid; idx < 2 * 2048 * 256; idx += gn) {
                const int s0 = (idx & 255) * 8, k = (idx >> 8) & 2047, part = idx >> 19; float v[8];
#pragma unroll
                for (int j = 0; j < 8; ++j) { const int p = (k * (s0 + j)) & 4095; float sv, cv; sincospif((float)p * (1.0f / 2048.0f), &sv, &cv); v[j] = (part ? sv : cv) * (1.0f / 64.0f); }
                u32x4 w; w.x = cvt_pk_bf16(v[0], v[1]); w.y = cvt_pk_bf16(v[2], v[3]); w.z = cvt_pk_bf16(v[4], v[5]); w.w = cvt_pk_bf16(v[6], v[7]);
                *(u32x4*)(CSM + (size_t)idx * 8) = w;
            }
            for (int idx = gtid; idx < 2 * 2 * 512; idx += gn) { const float x = P.in[18][idx]; NLS[idx] = -8.0f * __builtin_amdgcn_logf(1.0f + __builtin_amdgcn_exp2f(-x * LOG2E)); }
            if (blockIdx.x == 0 && tid < 128) KMAX[tid] = 0u;
            for (int idx = gtid; idx < 2 * 8192; idx += gn) ((float*)(ws + WS_MISC + MI_ALT))[idx] = 0.f;
            if (blockIdx.x == 0 && wid < 2) {
                const float a = wave_sum(P.in[7][wid * 64 + lane] * P.in[8][wid * 64 + lane]);
                const float b = wave_sum(P.in[9][wid * 64 + lane] * P.in[10][wid * 64 + lane]);
                int wq = wid; asm volatile("" : "+s"(wq)); const float li = wq == 0 ? 0.2f : 0.47071302f;
                if (lane == 0) LAMV[wid] = __builtin_amdgcn_exp2f(a * LOG2E) - __builtin_amdgcn_exp2f(b * LOG2E) + li;
            }
            rowpass(tid, P.in[0], nullptr, nullptr, nullptr, P.in[1], HN);
        } break;

        case PH_G1: { LANE_TID;
            pg8::Gemm g{HN, WIN + (size_t)e * INC_ * D_, D_, D_, D_, T_ / 256, INC_ / 256, 1, 0, 0};
            g.A2 = WIN + (size_t)e * INC_ * D_ + (size_t)2048 * D_; g.swapN = 8;
            pg8::EpiG1 E{QB, KB, VT, XR, GY};
            pg8::gemm_phase(lds, g, E, tid);
        } break;

        case PH_CONV: { LANE_TID;
            const float* cw = P.in[12] + (size_t)e * 4 * 512; const float* cb = P.in[13] + (size_t)e * 512;
            const int ch = lane * 8;
            float w[4][8], bb[8];
#pragma unroll
            for (int j = 0; j < 4; ++j)
#pragma unroll
                for (int i = 0; i < 8; ++i) w[j][i] = cw[j * 512 + ch + i];
#pragma unroll
            for (int i = 0; i < 8; ++i) bb[i] = cb[ch + i];
            for (int tb = blockIdx.x; tb < 256; tb += gridDim.x) {
                float kmx = 0.f;
                for (int it = 0; it < 4; ++it) {
                    const int t0 = tb * 128 + it * 32 + wid * 4, s0 = t0 & 4095;
                    u32x4 xr7[7], kv4[4];
#pragma unroll
                    for (int r = 0; r < 7; ++r) { const int ss = s0 + r - 2; xr7[r] = (u32x4){0u, 0u, 0u, 0u};
                        if (ss >= 0 && ss < S_) xr7[r] = *(const u32x4*)(XR + (size_t)(t0 + r - 2) * 512 + ch); }
#pragma unroll
                    for (int q = 0; q < 4; ++q) kv4[q] = *(const u32x4*)(KB + (size_t)(t0 + q) * 512 + ch);
#pragma unroll
                    for (int q = 0; q < 4; ++q) {
                        float accv[8];
#pragma unroll
                        for (int i = 0; i < 8; ++i) accv[i] = bb[i];
#pragma unroll
                        for (int j = 0; j < 4; ++j) { const u32x4 xv = xr7[q + j];
                            accv[0] += w[j][0] * bflo(xv.x); accv[1] += w[j][1] * bfhi(xv.x); accv[2] += w[j][2] * bflo(xv.y); accv[3] += w[j][3] * bfhi(xv.y);
                            accv[4] += w[j][4] * bflo(xv.z); accv[5] += w[j][5] * bfhi(xv.z); accv[6] += w[j][6] * bflo(xv.w); accv[7] += w[j][7] * bfhi(xv.w); }
                        u32x4 o; o.x = cvt_pk_bf16(accv[0], accv[1]); o.y = cvt_pk_bf16(accv[2], accv[3]); o.z = cvt_pk_bf16(accv[4], accv[5]); o.w = cvt_pk_bf16(accv[6], accv[7]);
                        *(u32x4*)(XC + (size_t)(t0 + q) * 512 + ch) = o;
                        const u32x4 kv = kv4[q];
                        float q2 = bflo(kv.x) * bflo(kv.x) + bfhi(kv.x) * bfhi(kv.x) + bflo(kv.y) * bflo(kv.y) + bfhi(kv.y) * bfhi(kv.y)
                                 + bflo(kv.z) * bflo(kv.z) + bfhi(kv.z) * bfhi(kv.z) + bflo(kv.w) * bflo(kv.w) + bfhi(kv.w) * bfhi(kv.w);
                        q2 += __shfl_xor(q2, 1); q2 += __shfl_xor(q2, 2); q2 += __shfl_xor(q2, 4);
                        kmx = fmaxf(kmx, q2);
                    }
                }
                if ((lane & 7) == 0) atomicMax(KMAX + e * 64 + (tb >> 5) * 8 + (lane >> 3), __float_as_uint(kmx));
            }
        } break;

        case PH_GATES: { LANE_TID;
            int kg_ = 128; asm volatile("" : "+s"(kg_));
            pg8::Gemm g{XC, WLRU + (size_t)e * 4 * 512 * 256, 512, 256, kg_, T_ / 256, 2, 4, 128, 512 * 256};
            pg8::EpiGates E{XC, P.in[15] + (size_t)e * 1024, P.in[17] + (size_t)e * 1024, NLS + e * 1024, AU};
            pg8::gemm_phase(lds, g, E, tid);
        } break;

        case PH_ATTN: { LANE_TID;
            for (int idx = blockIdx.x * 512 + tid; idx < 2 * 8 * 32 * 512; idx += gridDim.x * 512) {
                const int c = idx & 511, chunk = (idx >> 9) & 31, b = (idx >> 14) & 7, dir = idx >> 17;
                const unsigned* p = AU + ((size_t)dir * T_ + b * S_ + chunk * 128) * 512 + c;
                float LA = 0.f, H = 0.f;
                for (int s0 = 0; s0 < 128; s0 += 32) {
                    unsigned w[32];
#pragma unroll
                    for (int i = 0; i < 32; ++i) { const int s = dir == 0 ? (s0 + i) : (127 - s0 - i); w[i] = p[(size_t)s * 512]; }
#pragma unroll
                    for (int i = 0; i < 32; ++i) { const float la = bflo(w[i]); LA += la; H = __builtin_amdgcn_exp2f(la) * H + bfhi(w[i]); }
                }
                AGG[(((size_t)b * 32 + chunk) * 512 + c) * 2 + dir] = (f32x2){LA, H};
            }
            const int fr = lane & 15, fq = lane >> 4;
            const float lamv = LAMV[e];
            const float lam_init = l == 0 ? 0.2f : 0.47071302f;
            constexpr int KBUF = 16384, VBUF = 16384, BUFB = KBUF + VBUF;
            unsigned* AQ = (unsigned*)(ws + WS_MISC + MI_BAR) + (e * 8 + (int)(blockIdx.x & 7));
            LAS int* qslot = (LAS int*)(lds + LDS_MBW + 32);
            __syncthreads();
            if (tid == 0) *qslot = (int)atomicAdd(AQ, 1u);
            __syncthreads();
            int n_cur = *qslot;
            while (n_cur < 128) {
                unsigned n_nxt = 0u; if (tid == 0) n_nxt = atomicAdd(AQ, 1u);
                const int h = 3 - (n_cur >> 5), qb = n_cur & 31, b = (int)(blockIdx.x & 7);
                const int tok0 = b * S_, q0 = qb * 128 + wid * 16;
                const float slope2 = __builtin_amdgcn_exp2f(-2.0f * (float)(h + 1)) * LOG2E;
                bf16x8 Qf[2][2];
                float mb = 0.f, gap = 0.f;
#pragma unroll
                for (int mm = 0; mm < 2; ++mm) { float q2 = 0.f, sii = 0.f;
#pragma unroll
                    for (int ks = 0; ks < 2; ++ks) { Qf[mm][ks] = *(const bf16x8*)(QB + (size_t)(tok0 + q0 + fr) * 512 + h * 128 + mm * 64 + ks * 32 + fq * 8);
                        const bf16x8 kd = *(const bf16x8*)(KB + (size_t)(tok0 + q0 + fr) * 512 + h * 128 + mm * 64 + ks * 32 + fq * 8);
#pragma unroll
                        for (int j = 0; j < 8; ++j) { const float v = bf2f((unsigned short)Qf[mm][ks][j]); q2 += v * v; sii += v * bf2f((unsigned short)kd[j]); } }
                    q2 += __shfl_xor(q2, 16); q2 += __shfl_xor(q2, 32); sii += __shfl_xor(sii, 16); sii += __shfl_xor(sii, 32);
                    const float k2 = __uint_as_float(KMAX[e * 64 + b * 8 + h * 2 + mm]);
                    const float bm = __builtin_sqrtf(q2 * k2);
                    mb = fmaxf(mb, bm); gap = fmaxf(gap, bm - sii); }
                const f32x4 cinit = (f32x4){-mb, -mb, -mb, -mb};
                const float qf = (float)(q0 + fr);
                f32x4 o[2][8]; float lsum[2] = {0.f, 0.f};
#pragma unroll
                for (int mm = 0; mm < 2; ++mm)
#pragma unroll
                    for (int blk = 0; blk < 8; ++blk) o[mm][blk] = (f32x4){0.f, 0.f, 0.f, 0.f};
                const char* kbase = (const char*)(KB + (size_t)tok0 * 512 + h * 128); const char* vbase = (const char*)(VT + (size_t)(b * 512 + h * 128) * S_);
                unsigned goff[4];
#pragma unroll
                for (int i = 0; i < 4; ++i) { const int sg = ((wid & 3) * 4 + i) * 64 + lane, p = sg >> 8, w = sg & 255;
                    if (wid < 4) { const int lam = w >> 2, cpos = (w & 3) ^ ((lam >> 2) & 3);
                        const int key = (lam & 32) + 8 * ((lam & 15) >> 2) + 4 * ((lam >> 4) & 1) + (lam & 3); goff[i] = (unsigned)(key * 1024 + (cpos * 4 + p) * 16); }
                    else { const int d = w >> 1, kgp = (w & 1) ^ ((d >> 3) & 1); goff[i] = (unsigned)(d * 8192 + (kgp * 4 + p) * 16); } }
                unsigned kro[4], vro[2];
#pragma unroll
                for (int cp = 0; cp < 4; ++cp) kro[cp] = (unsigned)(fq * 4096 + fr * 64 + ((cp ^ ((fr >> 2) & 3)) << 4));
#pragma unroll
                for (int kg = 0; kg < 2; ++kg) vro[kg] = (unsigned)(fq * 4096 + fr * 32 + ((kg ^ ((fr >> 3) & 1)) << 4));
#define ATT_DMA(tt, sl) do { const char* gb_ = (wid < 4) ? (kbase + (size_t)(tt) * 65536) : (vbase + (size_t)(tt) * 128); \
                    _Pragma("unroll") for (int i = 0; i < 4; ++i) \
                        __builtin_amdgcn_global_load_lds((const unsigned*)(gb_ + goff[i]), (LAS unsigned*)(lds + (sl) * BUFB + (wid * 4 + i) * 1024), 16, 0, 0); } while (0)
#define ATT_WAIT_TILE() do { if (wid == 7) asm volatile("s_waitcnt vmcnt(2)" ::: "memory"); else asm volatile("s_waitcnt vmcnt(6)" ::: "memory"); } while (0)
                __syncthreads();
                { float mw = gap; mw = fmaxf(mw, __shfl_xor(mw, 1)); mw = fmaxf(mw, __shfl_xor(mw, 2)); mw = fmaxf(mw, __shfl_xor(mw, 4)); mw = fmaxf(mw, __shfl_xor(mw, 8));
                  if (lane == 0) ((LAS float*)(lds + LDS_MBW))[wid] = mw; }
                __syncthreads();
                float mbmax = 0.f;
#pragma unroll
                for (int w8 = 0; w8 < 8; ++w8) mbmax = fmaxf(mbmax, ((const LAS float*)(lds + LDS_MBW))[w8]);
                const float d0f = fminf((fmaxf(mbmax, 0.f) + 50.0f) / slope2, 8192.0f);
                const int d0 = (int)d0f + 1;
                int t_lo = (qb * 128 - d0 + 1); t_lo = t_lo < 0 ? 0 : (t_lo >> 6);
                int t_hi = (qb * 128 + 127 + d0 - 1) >> 6; t_hi = t_hi > 63 ? 63 : t_hi;
                t_lo = __builtin_amdgcn_readfirstlane(t_lo); t_hi = __builtin_amdgcn_readfirstlane(t_hi);
#define ATT_SOFTMAX(tt, kg, P8x) do { _Pragma("unroll") for (int ti = 0; ti < 2; ++ti) { const float dq = qf - (float)((tt) * 64 + (kg) * 32 + ti * 4 + fq * 8); \
                        _Pragma("unroll") for (int j = 0; j < 4; ++j) { const float bias = slope2 * __builtin_fabsf(dq - (float)j); \
                            _Pragma("unroll") for (int mm = 0; mm < 2; ++mm) { const float p = __builtin_amdgcn_exp2f(st[kg][mm][ti][j] - bias); st[kg][mm][ti][j] = p; lsum[mm] += p; } } } \
                        _Pragma("unroll") for (int mm = 0; mm < 2; ++mm) { u32x4 w; w.x = cvt_pk_nv(st[kg][mm][0][0], st[kg][mm][0][1]); w.y = cvt_pk_nv(st[kg][mm][0][2], st[kg][mm][0][3]); \
                            w.z = cvt_pk_nv(st[kg][mm][1][0], st[kg][mm][1][1]); w.w = cvt_pk_nv(st[kg][mm][1][2], st[kg][mm][1][3]); P8x[mm] = __builtin_bit_cast(bf16x8, w); } } while (0)
#define ATT_H1(tt, sl) do { const LAS unsigned char* kl = lds + (sl) * BUFB; bf16x8 kf[2][2][2][2]; \
                    _Pragma("unroll") for (int kg = 0; kg < 2; ++kg) _Pragma("unroll") for (int ti = 0; ti < 2; ++ti) _Pragma("unroll") for (int mm = 0; mm < 2; ++mm) _Pragma("unroll") for (int ks = 0; ks < 2; ++ks) \
                        kf[kg][ti][mm][ks] = *(const LAS bf16x8*)(kl + kro[mm * 2 + ks] + (kg * 32 + ti * 16) * 64); \
                    __builtin_amdgcn_sched_barrier(0); \
                    f32x4 st[2][2][2]; \
                    _Pragma("unroll") for (int kg = 0; kg < 2; ++kg) _Pragma("unroll") for (int ti = 0; ti < 2; ++ti) _Pragma("unroll") for (int mm = 0; mm < 2; ++mm) \
                        st[kg][mm][ti] = __builtin_amdgcn_mfma_f32_16x16x32_bf16(kf[kg][ti][mm][0], Qf[mm][0], cinit, 0, 0, 0); \
                    _Pragma("unroll") for (int kg = 0; kg < 2; ++kg) _Pragma("unroll") for (int ti = 0; ti < 2; ++ti) _Pragma("unroll") for (int mm = 0; mm < 2; ++mm) \
                        st[kg][mm][ti] = __builtin_amdgcn_mfma_f32_16x16x32_bf16(kf[kg][ti][mm][1], Qf[mm][1], st[kg][mm][ti], 0, 0, 0); \
                    __builtin_amdgcn_sched_barrier(0); \
                    ATT_SOFTMAX(tt, 0, P8a); ATT_SOFTMAX(tt, 1, P8b); \
                    __builtin_amdgcn_sched_barrier(0); } while (0)
#define ATT_H2(sl) do { const LAS unsigned char* vl = lds + (sl) * BUFB + KBUF; bf16x8 vf0[8], vf1[8]; \
                    _Pragma("unroll") for (int blk = 0; blk < 8; ++blk) vf0[blk] = *(const LAS bf16x8*)(vl + vro[0] + blk * 512); \
                    _Pragma("unroll") for (int blk = 0; blk < 8; ++blk) vf1[blk] = *(const LAS bf16x8*)(vl + vro[1] + blk * 512); \
                    __builtin_amdgcn_sched_barrier(0); \
                    _Pragma("unroll") for (int blk = 0; blk < 8; ++blk) { \
                        o[0][blk] = __builtin_amdgcn_mfma_f32_16x16x32_bf16(vf0[blk], P8a[0], o[0][blk], 0, 0, 0); \
                        o[1][blk] = __builtin_amdgcn_mfma_f32_16x16x32_bf16(vf0[blk], P8a[1], o[1][blk], 0, 0, 0); } \
                    _Pragma("unroll") for (int blk = 0; blk < 8; ++blk) { \
                        o[0][blk] = __builtin_amdgcn_mfma_f32_16x16x32_bf16(vf1[blk], P8b[0], o[0][blk], 0, 0, 0); \
                        o[1][blk] = __builtin_amdgcn_mfma_f32_16x16x32_bf16(vf1[blk], P8b[1], o[1][blk], 0, 0, 0); } \
                    __builtin_amdgcn_sched_barrier(0); } while (0)
                const int ntl = t_hi - t_lo + 1;
                const bool lag = wid >= 4;
                if (lag) __builtin_amdgcn_s_setprio(1);
                bf16x8 P8a[2], P8b[2];
                P8a[0] = P8a[1] = P8b[0] = P8b[1] = (bf16x8){0, 0, 0, 0, 0, 0, 0, 0};
                ATT_DMA(t_lo, 0);
                int slot = 0, pslot = 2;
                for (int it = 0; it <= ntl; ++it) {
                    asm volatile("s_waitcnt vmcnt(0)" ::: "memory");
                    __builtin_amdgcn_s_barrier(); asm volatile("" ::: "memory");
                    const int nslot = slot == 2 ? 0 : slot + 1;
                    if (it + 1 < ntl) ATT_DMA(t_lo + it + 1, nslot);
                    if (lag && it > 0) ATT_H2(pslot);
                    if (it < ntl) ATT_H1(t_lo + it, slot);
                    if (!lag && it < ntl) ATT_H2(slot);
                    pslot = slot; slot = nslot;
                }
#undef ATT_SOFTMAX
#undef ATT_H1
#undef ATT_H2
                __builtin_amdgcn_s_setprio(0);
                asm volatile("s_waitcnt vmcnt(0)" ::: "memory");
#undef ATT_DMA
#undef ATT_WAIT_TILE
                float l0 = lsum[0], l1 = lsum[1];
                l0 += __shfl_xor(l0, 16); l0 += __shfl_xor(l0, 32); l1 += __shfl_xor(l1, 16); l1 += __shfl_xor(l1, 32);
                const float i0 = 1.0f / l0, i1 = lamv / l1;
                float ss = 0.f;
#pragma unroll
                for (int blk = 0; blk < 8; ++blk)
#pragma unroll
                    for (int j = 0; j < 4; ++j) { const float v = o[0][blk][j] * i0 - o[1][blk][j] * i1; o[0][blk][j] = v; ss += v * v; }
                ss += __shfl_xor(ss, 16); ss += __shfl_xor(ss, 32);
                const float rn = __builtin_amdgcn_rsqf(ss * (1.0f / 128.0f) + EPS_) * (1.0f - lam_init);
                const float* sg = P.in[11] + e * 128;
                bf16_t* op = CAT + (size_t)(tok0 + q0 + fr) * D_ + h * 128 + fq * 4;
#pragma unroll
                for (int blk = 0; blk < 8; ++blk) { const f32x4 gv = *(const f32x4*)(sg + blk * 16 + fq * 4);
                    u32x2 w; w.x = cvt_pk_bf16(o[0][blk][0] * rn * gv[0], o[0][blk][1] * rn * gv[1]); w.y = cvt_pk_bf16(o[0][blk][2] * rn * gv[2], o[0][blk][3] * rn * gv[3]);
                    *(u32x2*)(op + blk * 16) = w; }
                __syncthreads();
                if (tid == 0) *qslot = (int)n_nxt;
                __syncthreads();
                n_cur = *qslot;
            }
        } break;

        case PH_SCAN2: { LANE_TID;
            for (int idx = blockIdx.x * 512 + tid; idx < 8 * 32 * 512; idx += gridDim.x * 512) {
                const int c = idx & 511, chunk = (idx >> 9) & 31, b = idx >> 14;
                const size_t tbase = (size_t)b * S_ + chunk * 128;
                float H = 0.f;
                for (int cc = 0; cc < chunk; ++cc) { const f32x2 ag = AGG[(((size_t)b * 32 + cc) * 512 + c) * 2 + 0]; H = __builtin_amdgcn_exp2f(ag.x) * H + ag.y; }
                float hfr[128];
                { const unsigned* p = AU + tbase * 512 + c;
#pragma unroll
                  for (int s0 = 0; s0 < 128; s0 += 32) {
                      unsigned w[32];
#pragma unroll
                      for (int i = 0; i < 32; ++i) w[i] = __builtin_nontemporal_load(p + (size_t)(s0 + i) * 512);
#pragma unroll
                      for (int i = 0; i < 32; ++i) { H = __builtin_amdgcn_exp2f(bflo(w[i])) * H + bfhi(w[i]); hfr[s0 + i] = H; }
                  } }
                H = 0.f;
                for (int cc = 31; cc > chunk; --cc) { const f32x2 ag = AGG[(((size_t)b * 32 + cc) * 512 + c) * 2 + 1]; H = __builtin_amdgcn_exp2f(ag.x) * H + ag.y; }
                { const unsigned* p = AU + ((size_t)T_ + tbase) * 512 + c; const bf16_t* gp = GY + tbase * 512 + c; bf16_t* op = CAT + tbase * D_ + 512 + c;
#pragma unroll
                  for (int s0 = 127; s0 >= 0; s0 -= 16) {
                      unsigned w[16]; unsigned short gv[16];
#pragma unroll
                      for (int i = 0; i < 16; ++i) { const size_t s = (size_t)(s0 - i); w[i] = __builtin_nontemporal_load(p + s * 512); gv[i] = __builtin_nontemporal_load(gp + s * 512); }
#pragma unroll
                      for (int i = 0; i < 16; ++i) { H = __builtin_amdgcn_exp2f(bflo(w[i])) * H + bfhi(w[i]);
                          const float rec = (hfr[s0 - i] + H) * bf2f(gv[i]); op[(size_t)(s0 - i) * D_] = (bf16_t)(cvt_pk_bf16(rec, 0.f) & 0xffffu); }
                  } }
            }
        } break;

        case PH_MIXOUT: { LANE_TID;
            pg8::Gemm g{CAT, WOUT + (size_t)e * D_ * D_, D_, D_, D_, T_ / 256, D_ / 256, 1, 0, 0};
            pg8::EpiPlain E{MB, D_, 0};
            pg8::gemm_phase(lds, g, E, tid);
        } break;
        case PH_FOUT: { LANE_TID;
            pg8::Gemm g{FB, WF + (size_t)e * D_ * D_, D_, D_, D_, T_ / 256, D_ / 256, 1, 0, 0};
            pg8::EpiPlain E{MB, D_, 0};
            pg8::gemm_phase(lds, g, E, tid);
        } break;
        case PH_FFN2: { LANE_TID;
            pg8::Gemm g{ACT, WD + (size_t)l * D_ * FF_, FF_, FF_, FF_, T_ / 256, D_ / 256, 1, 0, 0};
            pg8::EpiPlain E{FB, D_, 0};
            pg8::gemm_phase(lds, g, E, tid);
        } break;
        case PH_PRE: { LANE_TID;
            const int chn = (tid & 127) * 8, sl = tid >> 7;
            for (int wgi = blockIdx.x; wgi < 256; wgi += gridDim.x) {
                const int b = wgi >> 5, sbase = (wgi & 31) * 64;
                float al[8];
#pragma unroll
                for (int i = 0; i < 8; ++i) al[i] = 0.f;
                for (int it4 = 0; it4 < 4; ++it4) {
                    u32x4 av4[4], bv4[4];
#pragma unroll
                    for (int u4 = 0; u4 < 4; ++u4) { const int sq = sbase + (it4 * 4 + u4) * 4 + sl;
                        av4[u4] = __builtin_nontemporal_load((const u32x4*)(HN + ((size_t)b * S_ + sq) * D_ + chn));
                        bv4[u4] = (u32x4){0u, 0u, 0u, 0u};
                        if (sq) bv4[u4] = __builtin_nontemporal_load((const u32x4*)(HN + ((size_t)b * S_ + (S_ - sq)) * D_ + chn)); }
#pragma unroll
                    for (int u4 = 0; u4 < 4; ++u4) { const int sq = sbase + (it4 * 4 + u4) * 4 + sl; const u32x4 av = av4[u4], bv = bv4[u4];
                        const float a[8] = {bflo(av.x), bfhi(av.x), bflo(av.y), bfhi(av.y), bflo(av.z), bfhi(av.z), bflo(av.w), bfhi(av.w)};
                        const float m8[8] = {bflo(bv.x), bfhi(bv.x), bflo(bv.y), bfhi(bv.y), bflo(bv.z), bfhi(bv.z), bflo(bv.w), bfhi(bv.w)};
                        float he[8], ho[8]; const float sg = (sq & 1) ? -1.f : 1.f;
#pragma unroll
                        for (int i = 0; i < 8; ++i) { he[i] = a[i] + m8[i]; ho[i] = sq ? a[i] - m8[i] : 0.f; al[i] += sg * he[i]; }
                        u32x4 w; w.x = cvt_pk_bf16(he[0], he[1]); w.y = cvt_pk_bf16(he[2], he[3]); w.z = cvt_pk_bf16(he[4], he[5]); w.w = cvt_pk_bf16(he[6], he[7]);
                        *(u32x4*)(HE + ((size_t)b * 2048 + sq) * D_ + chn) = w;
                        w.x = cvt_pk_bf16(ho[0], ho[1]); w.y = cvt_pk_bf16(ho[2], ho[3]); w.z = cvt_pk_bf16(ho[4], ho[5]); w.w = cvt_pk_bf16(ho[6], ho[7]);
                        *(u32x4*)(HO + ((size_t)b * 2048 + sq) * D_ + chn) = w;
                        if (sq == 0) { const u32x4 cv = *(const u32x4*)(HN + ((size_t)b * S_ + 2048) * D_ + chn);
                            const float c8[8] = {bflo(cv.x), bfhi(cv.x), bflo(cv.y), bfhi(cv.y), bflo(cv.z), bfhi(cv.z), bflo(cv.w), bfhi(cv.w)};
#pragma unroll
                            for (int i = 0; i < 8; ++i) { al[i] += c8[i]; H2048[b * 1024 + chn + i] = c8[i]; } }
                    }
                }
#pragma unroll
                for (int i = 0; i < 8; ++i) atomicAdd(ALT + b * 1024 + chn + i, al[i]);
            }
        } break;
        case PH_DFTS: { LANE_TID;
            if (pflag) {
                pg8::Gemm g{CSM, YE, 2048, 4096, 2048, 8, 4, 16, 0, (long)1024 * 4096, 8, (long)2048 * 2048, 2048};
                pg8::EpiDftPQ E{PM, Y2048, FB};
                pg8::gemm_phase(lds, g, E, tid);
            } else {
                pg8::Gemm g{CSM, YE, 2048, 4096, 2048, 8, 4, 8, 0, (long)1024 * 4096};
                pg8::EpiF32 E{PM, D_, 2048};
                pg8::gemm_phase(lds, g, E, tid);
            }
        } break;
        case PH_DFTQ: { LANE_TID;
            pg8::Gemm g{CSM + (size_t)2048 * 2048, YE + 2048, 2048, 4096, 2048, 8, 4, 8, 0, (long)1024 * 4096};
            pg8::EpiDftQ E{PM, Y2048, FB};
            pg8::gemm_phase(lds, g, E, tid);
        } break;

        case PH_ROW1: { LANE_TID;
            rowpass(tid, l == 0 ? P.in[0] : P.out, nullptr, MB, P.in[2] + l * D_, P.in[3] + l * D_, HN);
        } break;
        case PH_ROW2: { LANE_TID;
            if (pflag) rowpass_fold(tid, l == 0 ? P.in[0] : P.out, P.out, MB, P.in[2] + l * D_, FB, P.in[4] + l * D_, P.in[1] + (l + 1) * D_, HE, HO, ALT0 + (l >> 1) * 8192, H2048);
            else rowpass(tid, P.out, P.out, MB, P.in[2] + l * D_, l < 3 ? P.in[1] + (l + 1) * D_ : nullptr, l < 3 ? HN : nullptr, FB, P.in[4] + l * D_);
        } break;

        case PH_FFN1: { LANE_TID;
            pg8::Gemm g{HN, WGU + (size_t)l * 2 * FF_ * D_, D_, D_, D_, T_ / 256, 2 * FF_ / 256, 1, 0, 0};
            pg8::EpiSwiglu E{ACT};
            pg8::gemm_phase(lds, g, E, tid);
        } break;

        case PH_DFTC: { LANE_TID;
            for (int task = blockIdx.x * 8 + wid; task < 8 * 1024; task += gridDim.x * 8) {
                const int b = task >> 10, col = task & 1023, gq = col >> 8, n = col & 255;
                const u32x2 wv = *(const u32x2*)(WDFT + (size_t)n * 256 + lane * 4);
                const f32x4 hv = *(const f32x4*)(H2048 + b * 1024 + gq * 256 + lane * 4), av = *(const f32x4*)(ALT + b * 1024 + gq * 256 + lane * 4);
                const float w0 = bflo(wv.x), w1 = bfhi(wv.x), w2 = bflo(wv.y), w3 = bfhi(wv.y);
                const float d1 = wave_sum(w0 * hv[0] + w1 * hv[1] + w2 * hv[2] + w3 * hv[3]);
                const float d2 = wave_sum(w0 * av[0] + w1 * av[1] + w2 * av[2] + w3 * av[3]);
                if (lane == 0) { Y2048[task] = d1; FB[((size_t)b * S_ + 2048) * D_ + col] = (bf16_t)(cvt_pk_bf16(d2 * (1.0f / 64.0f), 0.f) & 0xffffu); }
            }
            pg8::Gemm g{WDFT, HE, 256, D_, 256, 1, 8 * 2048 / 256, 8, 0, 256, 4, 256 * 256, (long)(32 * MiB / 2)};
            pg8::EpiDftC2 E{YE};
            pg8::gemm_phase(lds, g, E, tid);
        } break;
        default: break;
        }
        if (ph + 1 < ph_hi) {
            if (ph_hi < 0) grid.sync();
            else { const int ln_ = lane_id_asm();
                   xcd_barrier((unsigned*)(ws + WS_MISC + MI_BAR), (volatile LAS unsigned*)(lds + LDS_BARW), wave_s == 0 && ln_ == 0); }
        }
    }
}

extern "C" void kernel_launch(void* const* d_in, const int* in_sizes, int n_in, void* d_out, int out_size, void* d_ws, size_t ws_size, hipStream_t stream) {
    constexpr size_t kDynLds = LDS_TOTAL;
    static int grid_blocks = 0;
    if (!grid_blocks) {
        int dev = 0, cus = 0, per_cu = 0;
        hipGetDevice(&dev);
        hipDeviceGetAttribute(&cus, hipDeviceAttributeMultiprocessorCount, dev);
        hipFuncSetAttribute((const void*)fwd_megakernel, hipFuncAttributeMaxDynamicSharedMemorySize, (int)kDynLds);
        hipOccupancyMaxActiveBlocksPerMultiprocessor(&per_cu, fwd_megakernel, 512, kDynLds);
        if (per_cu < 1) per_cu = 1;
        grid_blocks = cus * per_cu;
        if (ws_size < WS_END) fprintf(stderr, "kernel_launch: workspace too small: %zu < %zu\n", ws_size, (size_t)WS_END);
    }
    (void)hipMemsetAsync((unsigned char*)d_ws + WS_MISC + MI_BAR, 0, BAR_BYTES, stream);
    Params p{};
    for (int i = 0; i < 23; ++i) p.in[i] = (const float*)d_in[i];
    p.out = (float*)d_out; p.ws = (unsigned char*)d_ws;
    int nph = 0;
    {
        auto add = [&](int type, int l) { p.tab[nph++] = (unsigned char)(type | (l << 4)); if ((PROBE_DUP >> type) & 1) p.tab[nph++] = (unsigned char)(type | (l << 4)); };
        add(PH_PREP, 0);
        for (int l = 0; l < 4; ++l) {
            if ((l & 1) == 0) { add(PH_G1, l); add(PH_CONV, l); add(PH_GATES, l); add(PH_ATTN, l); add(PH_SCAN2, l); add(PH_MIXOUT, l); }
            else { add(PH_DFTC, l); if (grid_blocks == 256) { add(PH_DFTS, l); p.tab[nph - 1] |= 64; } else { add(PH_DFTS, l); add(PH_DFTQ, l); } add(PH_FOUT, l); }
            add(PH_ROW1, l); add(PH_FFN1, l); add(PH_FFN2, l); add(PH_ROW2, l); if ((l & 1) == 0) p.tab[nph - 1] |= 64;
        }
    }
#if MULTI_LAUNCH
    for (int ph = 0; ph < nph; ++ph) {
        p.ph_lo = ph; p.ph_hi = ph + 1;
        void* args[] = {&p};
        hipError_t e = hipLaunchCooperativeKernel((void*)fwd_megakernel, dim3(grid_blocks), dim3(512), args, kDynLds, stream);
        if (e != hipSuccess) { fprintf(stderr, "cooperative launch failed: %s (grid %d)\n", hipGetErrorString(e), grid_blocks); break; }
    }
#else
    p.ph_lo = 0; p.ph_hi = nph;
    void* args[] = {&p};
    hipError_t e = hipLaunchCooperativeKernel((void*)fwd_megakernel, dim3(grid_blocks), dim3(512), args, kDynLds, stream);
    if (e != hipSuccess) fprintf(stderr, "cooperative launch failed: %s (grid %d)\n", hipGetErrorString(e), grid_blocks);
#endif
}
```

```cpp
#include <hip/hip_runtime.h>
#include <hip/hip_cooperative_groups.h>
#include <cstdio>
namespace cg = cooperative_groups;

#ifndef MULTI_LAUNCH
#define MULTI_LAUNCH 0
#endif
#define PROBE_DUP 0

#define LAS __attribute__((address_space(3)))
#define DI __device__ __forceinline__
typedef unsigned short bf16_t;
typedef short bf16x8 __attribute__((ext_vector_type(8)));
typedef float f32x4 __attribute__((ext_vector_type(4)));
typedef float f32x2 __attribute__((ext_vector_type(2)));
typedef unsigned u32x4 __attribute__((ext_vector_type(4)));
typedef unsigned u32x2 __attribute__((ext_vector_type(2)));

constexpr int T_ = 32768, D_ = 1024, S_ = 4096, FF_ = 2816, INC_ = 2560;
constexpr float EPS_ = 1e-6f;
constexpr float LOG2E = 1.4426950408889634f;

constexpr size_t MiB = 1024 * 1024;
constexpr size_t WS_WIN = 0;
constexpr size_t WS_WOUT = WS_WIN + 10 * MiB;
constexpr size_t WS_WF = WS_WOUT + 4 * MiB;
constexpr size_t WS_WGU = WS_WF + 4 * MiB;
constexpr size_t WS_WD = WS_WGU + 44 * MiB;
constexpr size_t WS_WLRU = WS_WD + 22 * MiB;
constexpr size_t WS_WDFT = WS_WLRU + 2 * MiB;
constexpr size_t WS_MISC = WS_WDFT + MiB / 4;
constexpr size_t WS_A = WS_MISC + 4 * MiB;
constexpr size_t WS_B = WS_A + 64 * MiB;
constexpr size_t WS_GY = WS_B + 128 * MiB;
constexpr size_t WS_E = WS_GY + 32 * MiB;
constexpr size_t WS_CS = WS_E + 176 * MiB;
constexpr size_t WS_END = WS_CS + 16 * MiB;
constexpr size_t MI_NLS = 0;
constexpr size_t MI_LAM = 8192;
constexpr size_t MI_KMAX = 8192 + 64;
constexpr size_t MI_AGG = 16384;
constexpr size_t MI_BAR = 16384 + 2 * 1024 * 1024;
constexpr size_t BAR_BYTES = 3456 * 4;
constexpr size_t MI_Y2048 = MI_BAR + 16384;
constexpr size_t MI_ALT = MI_Y2048 + 32768;
constexpr size_t MI_H2048 = MI_ALT + 65536;

constexpr int ATT_RING = 3 * 45056;
constexpr int LDS_BARW = ATT_RING;
constexpr int LDS_MBW = ATT_RING + 64;
constexpr int LDS_TOTAL = ATT_RING + 128;
struct Params { const float* in[23]; float* out; unsigned char* ws; int ph_lo, ph_hi; unsigned char tab[80]; };

DI unsigned cvt_pk_bf16(float lo, float hi) { unsigned r; asm("v_cvt_pk_bf16_f32 %0, %1, %2" : "=v"(r) : "v"(lo), "v"(hi)); return r; }
DI unsigned cvt_pk_nv(float lo, float hi) { unsigned r; asm("v_cvt_pk_bf16_f32 %0, %1, %2" : "=v"(r) : "v"(lo), "v"(hi)); return r; }
DI int lane_id_asm() { int l; asm volatile("v_mbcnt_lo_u32_b32 %0, -1, 0\n\tv_mbcnt_hi_u32_b32 %0, -1, %0" : "=v"(l)); return l; }
DI float bf2f(unsigned short b) { return __uint_as_float(((unsigned)b) << 16); }
DI float bflo(unsigned w) { return __uint_as_float(w << 16); }
DI float bfhi(unsigned w) { return __uint_as_float(w & 0xffff0000u); }
DI float sigmoidf_(float x) { return __builtin_amdgcn_rcpf(1.0f + __builtin_amdgcn_exp2f(-LOG2E * x)); }
DI float gelu_tanh(float y) { const float u = 1.5957691216057308f * (y + 0.044715f * y * y * y); return y * sigmoidf_(u); }
#define dpp_f(v, ctrl) __builtin_bit_cast(float, __builtin_amdgcn_update_dpp(0, __builtin_bit_cast(int, (v)), (ctrl), 0xf, 0xf, false))
DI float wave_sum(float v) {
    v += dpp_f(v, 0xB1); v += dpp_f(v, 0x4E); v += dpp_f(v, 0x141); v += dpp_f(v, 0x140);
    v += __shfl_xor(v, 16); v += __shfl_xor(v, 32); return v; }

namespace pg8 {
constexpr int BM = 256, BK = 64, HALF = 128, HTB = HALF * BK * 2, STAGE_BYTES = 8 * HTB, NXCD = 8, WGM = 8;
DI int lds_byte(int r, int c) { const int st = (r >> 4) * 2 + (c >> 5), rr = r & 15, cc = c & 31, ob = rr * 64 + cc * 2; return st * 1024 + (ob ^ (((ob >> 9) & 1) << 5)); }
DI void stage_rc(int b, int& R, int& C) { const int st = b / 1024, sb = b % 1024, swz = sb ^ (((sb >> 9) & 1) << 5); R = (st >> 1) * 16 + swz / 64; C = (st & 1) * 32 + (swz % 64) / 2; }
DI int perm32(int rho) { const int n = rho >> 4, i = rho & 15; return 8 * (i >> 2) + 4 * n + (i & 3); }

struct Unit { int pm, pn, z; };
struct Gemm { const bf16_t* A; const bf16_t* Bt; int lda, ldb, K, nM, nN, nZ; long sAz, sBz; int zdiv = 1 << 30; long sAhi = 0, sBhi = 0; const bf16_t* A2 = nullptr; int swapN = 1 << 30; };

struct Sched {
    int nM, nN, nwg, total, G, c;
    DI void init(int nM_, int nN_, int nZ_, int G_, int c_) { nM = nM_; nN = nN_; nwg = nM * nN; total = nwg * nZ_; G = G_; c = c_; }
    DI bool next(int i, Unit& u) const {
        const long L = (long)i * G + c; if (L >= total) return false;
        const int z = (int)(L / nwg); int wgid = (int)(L - (long)z * nwg);
        { const int q = nwg / NXCD, r = nwg % NXCD, xcd = wgid % NXCD, off = wgid / NXCD; wgid = (xcd < r ? xcd * (q + 1) : r * (q + 1) + (xcd - r) * q) + off; }
        const int nig = WGM * nN, gid = wgid / nig, fm = gid * WGM, gsz = (nM - fm) < WGM ? (nM - fm) : WGM;
        u.pm = fm + ((wgid % nig) % gsz); u.pn = (wgid % nig) / gsz; u.z = z; return true;
    }
};

template <class Epi>
DI void gemm_phase(LAS unsigned char* lds, const Gemm g, const Epi& E, const int tid) {
    const int wid = __builtin_amdgcn_readfirstlane(tid >> 6), lane = tid & 63, wr = wid >> 2, wc = wid & 3, fr = lane & 15, fq = lane >> 4;
    const int K = g.K, nt = K / BK;
    int bid_ = (int)blockIdx.x; asm volatile("" : "+s"(bid_));
    Sched S; S.init(g.nM, g.nN, g.nZ, (int)gridDim.x, bid_);
    unsigned voffA[2], voffB[2];
#pragma unroll
    for (int i = 0; i < 2; ++i) { int R, C; stage_rc(tid * 16 + i * 8192, R, C); const int Rb = Epi::PERM ? ((R & ~31) + perm32(R & 31)) : R;
        voffA[i] = (unsigned)(R * g.lda + C) * 2u; voffB[i] = (unsigned)(Rb * g.ldb + C) * 2u; }
    const size_t kstep = (size_t)(BK * 2);
    const size_t hstepA = (size_t)HALF * g.lda * 2, hstepB = (size_t)HALF * g.ldb * 2;
    const unsigned ldsw = (unsigned)wid * 1024u;
    const int aoff = lds_byte(wr * 64 + fr, fq * 8), boff = lds_byte(wc * 32 + fr, fq * 8);
#define PG8_APTR(u) ((u).pn >= g.swapN ? (const char*)(g.A2 + (size_t)((u).pn - g.swapN) * 256 * g.lda) : (const char*)(g.A + (size_t)((u).z % g.zdiv) * g.sAz + (size_t)((u).z / g.zdiv) * g.sAhi + (size_t)(u).pm * 256 * g.lda))
#define PG8_BPTR(u) ((u).pn >= g.swapN ? (const char*)(g.A + (size_t)(u).pm * 256 * g.lda) : (const char*)(g.Bt + (size_t)((u).z % g.zdiv) * g.sBz + (size_t)((u).z / g.zdiv) * g.sBhi + (size_t)(u).pn * 256 * g.ldb))
#define PG8_SA(b, h) (((b) * 2 + (h)) * HTB)
#define PG8_SB(b, h) ((4 + (b) * 2 + (h)) * HTB)
#define PG8_STAGE(bufoff, gbase, voff) do { _Pragma("unroll") for (int _i = 0; _i < 2; ++_i) \
        __builtin_amdgcn_global_load_lds((const unsigned*)((const char*)(gbase) + (voff)[_i]), (LAS unsigned*)(lds + (bufoff) + ldsw + _i * 8192), 16, 0, 0); } while (0)
#define PG8_LDA(dst, b, h) do { _Pragma("unroll") for (int m = 0; m < 4; ++m) _Pragma("unroll") for (int k = 0; k < 2; ++k) dst[m][k] = *(const LAS bf16x8*)(lds + PG8_SA(b, h) + aoff + m * 2048 + k * 1024); } while (0)
#define PG8_LDB(dst, b, h) do { _Pragma("unroll") for (int n = 0; n < 2; ++n) _Pragma("unroll") for (int k = 0; k < 2; ++k) dst[n][k] = *(const LAS bf16x8*)(lds + PG8_SB(b, h) + boff + n * 2048 + k * 1024); } while (0)
#define PG8_MMA(ai, bj, At, Bt) do { __builtin_amdgcn_s_setprio(1); _Pragma("unroll") for (int m = 0; m < 4; ++m) _Pragma("unroll") for (int n = 0; n < 2; ++n) _Pragma("unroll") for (int k = 0; k < 2; ++k) \
        acc[ai][bj][m][n] = __builtin_amdgcn_mfma_f32_16x16x32_bf16(Bt[n][k], At[m][k], acc[ai][bj][m][n], 0, 0, 0); __builtin_amdgcn_s_setprio(0); } while (0)
#define PG8_WAIT_V(n) asm volatile("s_waitcnt vmcnt(" #n ")" ::: "memory")
#define PG8_WAIT_L(n) asm volatile("s_waitcnt lgkmcnt(" #n ")" ::: "memory")
#define PG8_BAR __builtin_amdgcn_s_barrier()
#define PG8_SCHED __builtin_amdgcn_sched_barrier(0)
    Unit cur, nxt; int ui = 0;
    if (!S.next(0, cur)) return;
    f32x4 acc[2][2][4][2];
#pragma unroll
    for (int a = 0; a < 2; ++a)
#pragma unroll
        for (int b = 0; b < 2; ++b)
#pragma unroll
            for (int m = 0; m < 4; ++m)
#pragma unroll
                for (int n = 0; n < 2; ++n) acc[a][b][m][n] = (f32x4){0.f, 0.f, 0.f, 0.f};
    bf16x8 At[4][2], B0[2][2], B1[2][2];
    const char* cA = PG8_APTR(cur); const char* cB = PG8_BPTR(cur);
    PG8_STAGE(PG8_SB(0, 0), cB, voffB); PG8_STAGE(PG8_SA(0, 0), cA, voffA); PG8_STAGE(PG8_SB(0, 1), cB + hstepB, voffB); PG8_STAGE(PG8_SA(0, 1), cA + hstepA, voffA);
    if (wr == 1) PG8_BAR;
    PG8_WAIT_V(4); PG8_BAR;
    PG8_STAGE(PG8_SB(1, 0), cB + kstep, voffB); PG8_STAGE(PG8_SA(1, 0), cA + kstep, voffA); PG8_STAGE(PG8_SB(1, 1), cB + hstepB + kstep, voffB);
    PG8_WAIT_V(6); PG8_BAR;
    for (;;) {
        const bool has_next = S.next(ui + 1, nxt);
        const char* nA = has_next ? PG8_APTR(nxt) : cA; const char* nB = has_next ? PG8_BPTR(nxt) : cB;
        for (int t = 0; t < nt; t += 2) {
            const bool last = (t == nt - 2);
            const char* a1 = cA + (size_t)(t + 1) * kstep;
            const char* a2 = last ? nA : cA + (size_t)(t + 2) * kstep; const char* b2 = last ? nB : cB + (size_t)(t + 2) * kstep;
            const char* a3 = a2 + kstep; const char* b3 = b2 + kstep;
            PG8_LDB(B0, 0, 0); PG8_SCHED; PG8_LDA(At, 0, 0); PG8_STAGE(PG8_SA(1, 1), a1 + hstepA, voffA);
            PG8_WAIT_L(8); PG8_BAR; PG8_WAIT_L(0); PG8_MMA(0, 0, At, B0); PG8_BAR; PG8_SCHED;
            PG8_LDB(B1, 0, 1); PG8_STAGE(PG8_SB(0, 0), b2, voffB);
            PG8_BAR; PG8_WAIT_L(0); PG8_MMA(0, 1, At, B1); PG8_BAR;
            PG8_LDA(At, 0, 1); PG8_STAGE(PG8_SA(0, 0), a2, voffA);
            PG8_BAR; PG8_WAIT_L(0); PG8_MMA(1, 0, At, B0); PG8_BAR; PG8_SCHED;
            PG8_STAGE(PG8_SB(0, 1), b2 + hstepB, voffB);
            PG8_WAIT_V(6); PG8_BAR; PG8_MMA(1, 1, At, B1); PG8_BAR;
            PG8_LDB(B0, 1, 0); PG8_SCHED; PG8_LDA(At, 1, 0); PG8_STAGE(PG8_SA(0, 1), a2 + hstepA, voffA);
            PG8_WAIT_L(8); PG8_BAR; PG8_WAIT_L(0); PG8_MMA(0, 0, At, B0); PG8_BAR; PG8_SCHED;
            PG8_LDB(B1, 1, 1); PG8_STAGE(PG8_SB(1, 0), b3, voffB);
            PG8_BAR; PG8_WAIT_L(0); PG8_MMA(0, 1, At, B1); PG8_BAR;
            PG8_LDA(At, 1, 1); PG8_STAGE(PG8_SA(1, 0), a3, voffA);
            PG8_BAR; PG8_WAIT_L(0); PG8_MMA(1, 0, At, B0); PG8_BAR; PG8_SCHED;
            PG8_STAGE(PG8_SB(1, 1), b3 + hstepB, voffB);
            PG8_WAIT_V(6); PG8_BAR; PG8_MMA(1, 1, At, B1); PG8_BAR;
        }
        { const int lane_e = lane_id_asm();
          E(acc, cur, wr, wc, lane_e & 15, lane_e >> 4); }
        if (!has_next) break;
#pragma unroll
        for (int a = 0; a < 2; ++a)
#pragma unroll
            for (int b = 0; b < 2; ++b)
#pragma unroll
                for (int m = 0; m < 4; ++m)
#pragma unroll
                    for (int n = 0; n < 2; ++n) acc[a][b][m][n] = (f32x4){0.f, 0.f, 0.f, 0.f};
        cur = nxt; cA = nA; cB = nB; ++ui;
    }
    PG8_WAIT_V(0);
    if (wr == 0) PG8_BAR;
    PG8_BAR;
#undef PG8_APTR
#undef PG8_BPTR
#undef PG8_SA
#undef PG8_SB
#undef PG8_STAGE
#undef PG8_LDA
#undef PG8_LDB
#undef PG8_MMA
#undef PG8_WAIT_V
#undef PG8_WAIT_L
#undef PG8_BAR
#undef PG8_SCHED
}

struct EpiPlain {
    static constexpr bool PERM = true;
    bf16_t* O; int ldc; int zrows;
    DI void operator()(const f32x4 (&acc)[2][2][4][2], const Unit& u, int wr, int wc, int fr, int fq) const {
        const int row0 = u.z * zrows + u.pm * BM + wr * 64 + fr, col0 = u.pn * BM + wc * 32 + 8 * fq;
#pragma unroll
        for (int ai = 0; ai < 2; ++ai)
#pragma unroll
            for (int m = 0; m < 4; ++m) { bf16_t* rowp = O + (size_t)(row0 + ai * HALF + m * 16) * ldc + col0;
#pragma unroll
                for (int bj = 0; bj < 2; ++bj) { const f32x4 v0 = acc[ai][bj][m][0], v1 = acc[ai][bj][m][1];
                    u32x4 w; w.x = cvt_pk_bf16(v0[0], v0[1]); w.y = cvt_pk_bf16(v0[2], v0[3]); w.z = cvt_pk_bf16(v1[0], v1[1]); w.w = cvt_pk_bf16(v1[2], v1[3]);
                    *(u32x4*)(rowp + bj * HALF) = w; } }
    }
};
struct EpiSwiglu {
    static constexpr bool PERM = true;
    bf16_t* O;
    DI void operator()(const f32x4 (&acc)[2][2][4][2], const Unit& u, int wr, int wc, int fr, int fq) const {
        const int row0 = u.pm * BM + wr * 64 + fr, col0 = u.pn * HALF + wc * 32 + 8 * fq;
#pragma unroll
        for (int ai = 0; ai < 2; ++ai)
#pragma unroll
            for (int m = 0; m < 4; ++m) { bf16_t* rowp = O + (size_t)(row0 + ai * HALF + m * 16) * FF_ + col0;
                float ex[8], r[8];
#pragma unroll
                for (int i = 0; i < 8; ++i) ex[i] = __builtin_amdgcn_exp2f(-LOG2E * acc[ai][0][m][i >> 2][i & 3]);
#pragma unroll
                for (int i = 0; i < 8; ++i) ex[i] = __builtin_amdgcn_rcpf(1.0f + ex[i]);
#pragma unroll
                for (int i = 0; i < 8; ++i) r[i] = acc[ai][0][m][i >> 2][i & 3] * ex[i] * acc[ai][1][m][i >> 2][i & 3];
                u32x4 w; w.x = cvt_pk_nv(r[0], r[1]); w.y = cvt_pk_nv(r[2], r[3]); w.z = cvt_pk_nv(r[4], r[5]); w.w = cvt_pk_nv(r[6], r[7]);
                *(u32x4*)rowp = w; }
    }
};
struct EpiG1 {
    static constexpr bool PERM = true;
    bf16_t *q, *k, *vt, *xr, *gy;
    DI void operator()(const f32x4 (&acc)[2][2][4][2], const Unit& u, int wr, int wc, int fr, int fq) const {
        const int row0 = u.pm * BM + wr * 64 + fr;
        if (u.pn >= 8) {
            const int r0 = (u.pn - 8) * BM + wr * 64 + fr, t0 = u.pm * BM + wc * 32 + 8 * fq;
#pragma unroll
            for (int ai = 0; ai < 2; ++ai)
#pragma unroll
                for (int m = 0; m < 4; ++m) { const int vrow = r0 + ai * HALF + m * 16;
#pragma unroll
                    for (int bj = 0; bj < 2; ++bj) { const int t = t0 + bj * HALF; const int b = t >> 12, sq = t & 4095;
                        const f32x4 v0 = acc[ai][bj][m][0], v1 = acc[ai][bj][m][1];
                        u32x4 w; w.x = cvt_pk_bf16(v0[0], v0[1]); w.y = cvt_pk_bf16(v0[2], v0[3]); w.z = cvt_pk_bf16(v1[0], v1[1]); w.w = cvt_pk_bf16(v1[2], v1[3]);
                        *(u32x4*)(vt + ((size_t)(b * 512 + vrow)) * S_ + sq) = w; } }
            return;
        }
        const int sec = u.pn >> 1;
        const int colb = (u.pn & 1) * BM + wc * 32 + 8 * fq;
        bf16_t* base = sec == 0 ? q : (sec == 1 ? k : (sec == 2 ? xr : gy));
        const float sc = sec == 0 ? (0.125f * LOG2E) : 1.0f;
#pragma unroll
        for (int ai = 0; ai < 2; ++ai)
#pragma unroll
            for (int m = 0; m < 4; ++m) { bf16_t* rowp = base + (size_t)(row0 + ai * HALF + m * 16) * 512 + colb;
#pragma unroll
                for (int bj = 0; bj < 2; ++bj) { f32x4 v0 = acc[ai][bj][m][0] * sc, v1 = acc[ai][bj][m][1] * sc;
                    if (sec == 3) {
                        float ge[8];
#pragma unroll
                        for (int j = 0; j < 8; ++j) { const float y = j < 4 ? v0[j & 3] : v1[j & 3]; ge[j] = __builtin_amdgcn_exp2f(-LOG2E * 1.5957691216057308f * (y + 0.044715f * y * y * y)); }
#pragma unroll
                        for (int j = 0; j < 8; ++j) ge[j] = __builtin_amdgcn_rcpf(1.0f + ge[j]);
#pragma unroll
                        for (int j = 0; j < 4; ++j) { v0[j] *= ge[j]; v1[j] *= ge[4 + j]; } }
                    u32x4 w; w.x = cvt_pk_bf16(v0[0], v0[1]); w.y = cvt_pk_bf16(v0[2], v0[3]); w.z = cvt_pk_bf16(v1[0], v1[1]); w.w = cvt_pk_bf16(v1[2], v1[3]);
                    *(u32x4*)(rowp + bj * HALF) = w; } }
    }
};
struct EpiGates {
    static constexpr bool PERM = false;
    const bf16_t* xc; const float* ba; const float* bi; const float* nls; unsigned* au;
    DI void operator()(const f32x4 (&acc)[2][2][4][2], const Unit& u, int wr, int wc, int fr, int fq) const {
        const int row0 = u.pm * BM + wr * 64 + fr, dir = u.pn;
#pragma unroll
        for (int n = 0; n < 2; ++n) {
            const int c = u.z * 128 + wc * 32 + 16 * n + 4 * fq;
            const f32x4 bav = *(const f32x4*)(ba + dir * 512 + c), biv = *(const f32x4*)(bi + dir * 512 + c), nl = *(const f32x4*)(nls + dir * 512 + c);
#pragma unroll
            for (int ai = 0; ai < 2; ++ai)
#pragma unroll
                for (int m = 0; m < 4; ++m) { const int row = row0 + ai * HALF + m * 16;
                    const u32x2 xw = *(const u32x2*)(xc + (size_t)row * 512 + c);
                    const float xv[4] = {bflo(xw.x), bfhi(xw.x), bflo(xw.y), bfhi(xw.y)};
                    u32x4 w; float e1[4], e2[4], la[4], sq[4];
#pragma unroll
                    for (int j = 0; j < 4; ++j) { e1[j] = __builtin_amdgcn_exp2f(-LOG2E * (acc[ai][0][m][n][j] + bav[j])); e2[j] = __builtin_amdgcn_exp2f(-LOG2E * (acc[ai][1][m][n][j] + biv[j])); }
#pragma unroll
                    for (int j = 0; j < 4; ++j) { e1[j] = __builtin_amdgcn_rcpf(1.0f + e1[j]); e2[j] = __builtin_amdgcn_rcpf(1.0f + e2[j]); }
#pragma unroll
                    for (int j = 0; j < 4; ++j) { la[j] = e1[j] * nl[j]; sq[j] = __builtin_amdgcn_exp2f(2.0f * la[j]); }
#pragma unroll
                    for (int j = 0; j < 4; ++j) sq[j] = __builtin_amdgcn_sqrtf(fmaxf(1.0f - sq[j], 0.f));
#pragma unroll
                    for (int j = 0; j < 4; ++j) w[j] = cvt_pk_nv(la[j], sq[j] * e2[j] * xv[j]);
                    *(u32x4*)(au + ((size_t)dir * T_ + row) * 512 + c) = w; }
        }
    }
};
struct EpiDftC {
    static constexpr bool PERM = true;
    bf16_t* Yt;
    DI void operator()(const f32x4 (&acc)[2][2][4][2], const Unit& u, int wr, int wc, int fr, int fq) const {
        const int nl0 = wr * 64 + fr, t0 = u.pn * BM + wc * 32 + 8 * fq;
#pragma unroll
        for (int ai = 0; ai < 2; ++ai)
#pragma unroll
            for (int m = 0; m < 4; ++m) { const int nl = nl0 + ai * HALF + m * 16;
#pragma unroll
                for (int bj = 0; bj < 2; ++bj) { const int t = t0 + bj * HALF; const int b = t >> 12, s = t & 4095;
                    const f32x4 v0 = acc[ai][bj][m][0], v1 = acc[ai][bj][m][1];
                    u32x4 w; w.x = cvt_pk_bf16(v0[0], v0[1]); w.y = cvt_pk_bf16(v0[2], v0[3]); w.z = cvt_pk_bf16(v1[0], v1[1]); w.w = cvt_pk_bf16(v1[2], v1[3]);
                    *(u32x4*)(Yt + (((size_t)(b * 1024 + u.z * 256 + nl)) * 2 + u.pm) * S_ + s) = w; } }
    }
};


struct EpiDftC2 {
    static constexpr bool PERM = true;
    bf16_t* Ye;
    DI void operator()(const f32x4 (&acc)[2][2][4][2], const Unit& u, int wr, int wc, int fr, int fq) const {
        const int nl0 = wr * 64 + fr, t0 = u.pn * BM + wc * 32 + 8 * fq, part = u.z >> 2, gq = u.z & 3;
#pragma unroll
        for (int ai = 0; ai < 2; ++ai)
#pragma unroll
            for (int m = 0; m < 4; ++m) { const int nl = nl0 + ai * HALF + m * 16;
#pragma unroll
                for (int bj = 0; bj < 2; ++bj) { const int t = t0 + bj * HALF; const int b = t >> 11, sq = t & 2047;
                    const f32x4 v0 = acc[ai][bj][m][0], v1 = acc[ai][bj][m][1];
                    u32x4 w; w.x = cvt_pk_bf16(v0[0], v0[1]); w.y = cvt_pk_bf16(v0[2], v0[3]); w.z = cvt_pk_bf16(v1[0], v1[1]); w.w = cvt_pk_bf16(v1[2], v1[3]);
                    *(u32x4*)(Ye + (((size_t)(b * 1024 + gq * 256 + nl)) * 2 + part) * 2048 + sq) = w; } }
    }
};

struct EpiF32 {
    static constexpr bool PERM = false;
    float* C; int ldc; int zrows;
    DI void operator()(const f32x4 (&acc)[2][2][4][2], const Unit& u, int wr, int wc, int fr, int fq) const {
        const int row0 = u.z * zrows + u.pm * BM + wr * 64 + fr, col0 = u.pn * BM + wc * 32 + 4 * fq;
#pragma unroll
        for (int ai = 0; ai < 2; ++ai)
#pragma unroll
            for (int m = 0; m < 4; ++m) { float* rowp = C + (size_t)(row0 + ai * HALF + m * 16) * ldc + col0;
#pragma unroll
                for (int bj = 0; bj < 2; ++bj)
#pragma unroll
                    for (int n = 0; n < 2; ++n) *(f32x4*)(rowp + bj * HALF + n * 16) = acc[ai][bj][m][n]; }
    }
};
struct EpiDftQ {
    static constexpr bool PERM = false;
    const float* Pm; const float* y2048; bf16_t* F;
    DI void operator()(const f32x4 (&acc)[2][2][4][2], const Unit& u, int wr, int wc, int fr, int fq) const {
        const int k0 = u.pm * BM + wr * 64 + fr, col0 = u.pn * BM + wc * 32 + 4 * fq, b = u.z;
#pragma unroll
        for (int bj = 0; bj < 2; ++bj)
#pragma unroll
            for (int n = 0; n < 2; ++n) { const int c = col0 + bj * HALF + n * 16;
                const f32x4 yv = *(const f32x4*)(y2048 + b * 1024 + c) * (1.0f / 64.0f);
#pragma unroll
                for (int ai = 0; ai < 2; ++ai)
#pragma unroll
                    for (int m = 0; m < 4; ++m) { const int k = k0 + ai * HALF + m * 16;
                        const f32x4 pv = __builtin_nontemporal_load((const f32x4*)(Pm + ((size_t)(b * 2048 + k)) * 1024 + c)) + ((k & 1) ? -yv : yv);
                        const f32x4 q = acc[ai][bj][m][n]; const f32x4 f1 = pv - q, f2 = pv + q;
                        u32x2 w1; w1.x = cvt_pk_bf16(f1[0], f1[1]); w1.y = cvt_pk_bf16(f1[2], f1[3]);
                        *(u32x2*)(F + ((size_t)(b * 4096 + k)) * 1024 + c) = w1;
                        if (k) { u32x2 w2; w2.x = cvt_pk_bf16(f2[0], f2[1]); w2.y = cvt_pk_bf16(f2[2], f2[3]); *(u32x2*)(F + ((size_t)(b * 4096 + 4096 - k)) * 1024 + c) = w2; }
                        asm volatile("" ::: "memory"); }
            }
    }
};

struct EpiDftPQ {
    static constexpr bool PERM = false;
    float* Pm; const float* y2048; bf16_t* F;
    DI void operator()(const f32x4 (&acc)[2][2][4][2], const Unit& u, int wr, int wc, int fr, int fq) const {
        if (u.z < 8) { const EpiF32 e{Pm, D_, 2048}; e(acc, u, wr, wc, fr, fq); }
        else { Unit v = u; v.z = u.z - 8; const EpiDftQ e{Pm, y2048, F}; e(acc, v, wr, wc, fr, fq); }
    }
};
}


#define XB_TMO      128
#define XB_XCNT(j)  (256  + 64 * (j))
#define XB_XSUB(j)  (1280 + 64 * (j))
#define XB_XGEN(j)  (2304 + 64 * (j))
#define XB_TOP      3328
#define XB_TOPGEN   3392
#define XCD_BAR_WORDS 3456
#define XB_SPIN_CAP (1u << 20)
DI unsigned xb_ld(unsigned* p)              { return __hip_atomic_load(p, __ATOMIC_RELAXED, __HIP_MEMORY_SCOPE_AGENT); }
DI unsigned xb_add(unsigned* p, unsigned v) { return __hip_atomic_fetch_add(p, v, __ATOMIC_RELAXED, __HIP_MEMORY_SCOPE_AGENT); }
DI unsigned xb_xcc_id() { return (unsigned)__builtin_amdgcn_s_getreg((3 << 11) | 20) & 0xFu; }
#define XB_SPIN(cond, bar) do { unsigned _sp = 0; while (cond) { __builtin_amdgcn_s_sleep(1); \
    if ((++_sp & 255u) == 0u) { if (xb_ld(&(bar)[XB_TMO])) break; if (_sp > XB_SPIN_CAP) { atomicAdd(&(bar)[XB_TMO], 1u); break; } } } } while (0)
DI void xcd_barrier_complete(unsigned* bar, unsigned x, unsigned& nloc, unsigned& nx) {
    const unsigned G = gridDim.x;
    unsigned sum, cnt, mine, sp = 0u;
    for (;;) {
        sum = 0u; cnt = 0u; mine = 0u;
#pragma unroll
        for (unsigned j = 0; j < 16; ++j) { const unsigned c = xb_ld(&bar[XB_XCNT(j)]); sum += c; cnt += (c > 0u) ? 1u : 0u; mine = (j == x) ? c : mine; }
        if (sum == G) break;
        __builtin_amdgcn_s_sleep(1);
        if ((++sp & 255u) == 0u) { if (xb_ld(&bar[XB_TMO])) break; if (sp > XB_SPIN_CAP) { atomicAdd(&bar[XB_TMO], 1u); break; } }
    }
    nloc = mine > 0u ? mine : 1u; nx = cnt > 0u ? cnt : 1u;
}
DI void xcd_barrier(unsigned* bar, volatile LAS unsigned* st, bool leader) {
    asm volatile("s_waitcnt vmcnt(0)" ::: "memory");
    __syncthreads();
    if (leader) {
        const unsigned x = xb_xcc_id();
        __builtin_amdgcn_s_waitcnt(0);
        unsigned nloc = st[0], nx = st[1];
        if (nloc == 0u) { xcd_barrier_complete(bar, x, nloc, nx); st[0] = nloc; st[1] = nx; }
        const unsigned old = xb_add(&bar[XB_XSUB(x)], 1u);
        const unsigned gen = old / nloc;
        if (old + 1u == (gen + 1u) * nloc) {
            __builtin_amdgcn_fence(__ATOMIC_RELEASE, "agent");
            asm volatile("s_waitcnt vmcnt(0)" ::: "memory");
            const unsigned og = xb_add(&bar[XB_TOP], 1u);
            const unsigned tg = og / nx;
            if (og + 1u == (tg + 1u) * nx) xb_add(&bar[XB_TOPGEN], 1u);
            else XB_SPIN(xb_ld(&bar[XB_TOPGEN]) == tg, bar);
            __builtin_amdgcn_fence(__ATOMIC_ACQUIRE, "agent");
            xb_add(&bar[XB_XGEN(x)], 1u);
            asm volatile("s_waitcnt vmcnt(0)" ::: "memory");
        } else {
            XB_SPIN(xb_ld(&bar[XB_XGEN(x)]) == gen, bar);
            __builtin_amdgcn_fence(__ATOMIC_ACQUIRE, "agent");
            asm volatile("s_waitcnt vmcnt(0)" ::: "memory");
        }
    }
    __syncthreads();
}

DI void transpose_cvt(const int tid, LAS float* tl, const float* src, int K, int N, bf16_t* dst, int ldd, int mode) {
    const int tk = K / 64, tn = N / 64;
    for (int tile = blockIdx.x; tile < tk * tn; tile += gridDim.x) {
        const int k0 = (tile / tn) * 64, n0 = (tile % tn) * 64;
        __syncthreads();
#pragma unroll
        for (int i = 0; i < 8; ++i) { const int kk = (tid >> 6) + 8 * i, nn = tid & 63; tl[kk * 65 + nn] = __builtin_nontemporal_load(src + (size_t)(k0 + kk) * N + n0 + nn); }
        __syncthreads();
        const int nl = tid >> 3, kc = tid & 7; float v[8];
#pragma unroll
        for (int j = 0; j < 8; ++j) v[j] = tl[(kc * 8 + j) * 65 + nl];
        const int n = n0 + nl; const int drow = mode == 0 ? n : (mode == 3 ? (n < 1024 ? n : (n < 1536 ? n + 1024 : n - 512)) : ((n >> 7) * 256 + (n & 127) + (mode == 2 ? 128 : 0)));
        u32x4 w; w.x = cvt_pk_bf16(v[0], v[1]); w.y = cvt_pk_bf16(v[2], v[3]); w.z = cvt_pk_bf16(v[4], v[5]); w.w = cvt_pk_bf16(v[6], v[7]);
        *(u32x4*)(dst + (size_t)drow * ldd + k0 + kc * 8) = w;
    }
}

DI void rowpass(const int tid, const float* xin, float* xout, const bf16_t* m, const float* gpost, const float* gnext, bf16_t* hn, const bf16_t* m2 = nullptr, const float* gpost2 = nullptr) {
    const int lane = tid & 63, wid = tid >> 6;
    const int stride = gridDim.x * 16;
    int row0 = (blockIdx.x * 8 + wid) * 2;
    f32x4 x[2][4]; u32x2 mw[2][4], mw2[2][4];
#define ROW_LOAD(X, M, M2, R0) do { _Pragma("unroll") for (int r = 0; r < 2; ++r) _Pragma("unroll") for (int i = 0; i < 4; ++i) { \
        X[r][i] = __builtin_nontemporal_load((const f32x4*)(xin + (size_t)((R0) + r) * D_ + i * 256 + lane * 4)); \
        if (m) M[r][i] = __builtin_nontemporal_load((const u32x2*)(m + (size_t)((R0) + r) * D_ + i * 256 + lane * 4)); \
        if (m2) M2[r][i] = __builtin_nontemporal_load((const u32x2*)(m2 + (size_t)((R0) + r) * D_ + i * 256 + lane * 4)); } } while (0)
    if (row0 < T_) ROW_LOAD(x, mw, mw2, row0);
    for (; row0 < T_; row0 += stride) {
        f32x4 xn[2][4]; u32x2 mn[2][4], mn2[2][4];
        const int nrow = row0 + stride;
        if (nrow < T_) ROW_LOAD(xn, mn, mn2, nrow);
        if (m) {
#pragma unroll
            for (int r = 0; r < 2; ++r) {
                f32x4 mv[4]; float ss = 0.f;
#pragma unroll
                for (int i = 0; i < 4; ++i) { const u32x2 w = mw[r][i];
                    mv[i] = (f32x4){bflo(w.x), bfhi(w.x), bflo(w.y), bfhi(w.y)}; ss += mv[i][0] * mv[i][0] + mv[i][1] * mv[i][1] + mv[i][2] * mv[i][2] + mv[i][3] * mv[i][3]; }
                ss = wave_sum(ss); const float rr = __builtin_amdgcn_rsqf(ss * (1.0f / D_) + EPS_);
#pragma unroll
                for (int i = 0; i < 4; ++i) { const f32x4 gp = *(const f32x4*)(gpost + i * 256 + lane * 4); x[r][i] += mv[i] * rr * gp; }
                if (m2) {
                    float s2 = 0.f;
#pragma unroll
                    for (int i = 0; i < 4; ++i) { const u32x2 w = mw2[r][i];
                        mv[i] = (f32x4){bflo(w.x), bfhi(w.x), bflo(w.y), bfhi(w.y)}; s2 += mv[i][0] * mv[i][0] + mv[i][1] * mv[i][1] + mv[i][2] * mv[i][2] + mv[i][3] * mv[i][3]; }
                    s2 = wave_sum(s2); const float r2 = __builtin_amdgcn_rsqf(s2 * (1.0f / D_) + EPS_);
#pragma unroll
                    for (int i = 0; i < 4; ++i) { const f32x4 gp = *(const f32x4*)(gpost2 + i * 256 + lane * 4); x[r][i] += mv[i] * r2 * gp; }
                }
                if (xout) {
#pragma unroll
                    for (int i = 0; i < 4; ++i) __builtin_nontemporal_store(x[r][i], (f32x4*)(xout + (size_t)(row0 + r) * D_ + i * 256 + lane * 4)); }
            }
        }
        if (hn) {
#pragma unroll
            for (int r = 0; r < 2; ++r) {
                float ss = 0.f;
#pragma unroll
                for (int i = 0; i < 4; ++i) ss += x[r][i][0] * x[r][i][0] + x[r][i][1] * x[r][i][1] + x[r][i][2] * x[r][i][2] + x[r][i][3] * x[r][i][3];
                ss = wave_sum(ss); const float rr = __builtin_amdgcn_rsqf(ss * (1.0f / D_) + EPS_);
#pragma unroll
                for (int i = 0; i < 4; ++i) { const f32x4 gn = *(const f32x4*)(gnext + i * 256 + lane * 4); const f32x4 y = x[r][i] * rr * gn;
                    u32x2 w; w.x = cvt_pk_bf16(y[0], y[1]); w.y = cvt_pk_bf16(y[2], y[3]); *(u32x2*)(hn + (size_t)(row0 + r) * D_ + i * 256 + lane * 4) = w; }
            }
        }
#pragma unroll
        for (int r = 0; r < 2; ++r)
#pragma unroll
            for (int i = 0; i < 4; ++i) { x[r][i] = xn[r][i]; mw[r][i] = mn[r][i]; mw2[r][i] = mn2[r][i]; }
    }
#undef ROW_LOAD
}

DI void rowpass_fold(const int tid, const float* xin, float* xout, const bf16_t* m, const float* gpost, const bf16_t* m2, const float* gpost2, const float* gnext, bf16_t* He, bf16_t* Ho, float* alt, float* h2048) {
    const int lane = tid & 63, wid = tid >> 6;
    const int nW = gridDim.x * 8;
    f32x4 x[2][4]; u32x2 mw[2][4], mw2[2][4];
#define FOLD_ROWS(IDX, B, SQ, RA, RB) const int B = ((IDX) & 2047) >> 8, SQ = ((IDX) & 255) + 256 * ((IDX) >> 11); const int RA = B * S_ + SQ, RB = B * S_ + (SQ ? S_ - SQ : 2048)
#define FOLD_LOAD(X, M, M2, RA, RB) do { _Pragma("unroll") for (int i = 0; i < 4; ++i) { \
        X[0][i] = __builtin_nontemporal_load((const f32x4*)(xin + (size_t)(RA) * D_ + i * 256 + lane * 4)); X[1][i] = __builtin_nontemporal_load((const f32x4*)(xin + (size_t)(RB) * D_ + i * 256 + lane * 4)); \
        M[0][i] = __builtin_nontemporal_load((const u32x2*)(m + (size_t)(RA) * D_ + i * 256 + lane * 4)); M[1][i] = __builtin_nontemporal_load((const u32x2*)(m + (size_t)(RB) * D_ + i * 256 + lane * 4)); \
        M2[0][i] = __builtin_nontemporal_load((const u32x2*)(m2 + (size_t)(RA) * D_ + i * 256 + lane * 4)); M2[1][i] = __builtin_nontemporal_load((const u32x2*)(m2 + (size_t)(RB) * D_ + i * 256 + lane * 4)); } } while (0)
    int idx = blockIdx.x * 8 + wid;
    f32x4 al[4]; int curb = -1;
#pragma unroll
    for (int i = 0; i < 4; ++i) al[i] = (f32x4){0.f, 0.f, 0.f, 0.f};
    if (idx < 16384) { FOLD_ROWS(idx, b0_, s0_, ra0_, rb0_); (void)b0_; (void)s0_; FOLD_LOAD(x, mw, mw2, ra0_, rb0_); }
    for (; idx < 16384; idx += nW) {
        FOLD_ROWS(idx, b, sq, rA, rB);
        f32x4 xn[2][4]; u32x2 mn[2][4], mn2[2][4];
        const int nidx = idx + nW;
        if (nidx < 16384) { FOLD_ROWS(nidx, b1_, s1_, ra1_, rb1_); (void)b1_; (void)s1_; FOLD_LOAD(xn, mn, mn2, ra1_, rb1_); }
        if (b != curb) {
            if (curb >= 0) {
#pragma unroll
                for (int i = 0; i < 4; ++i)
#pragma unroll
                    for (int j = 0; j < 4; ++j) atomicAdd(alt + curb * 1024 + i * 256 + lane * 4 + j, al[i][j]); }
#pragma unroll
            for (int i = 0; i < 4; ++i) al[i] = (f32x4){0.f, 0.f, 0.f, 0.f};
            curb = b;
        }
        f32x4 hv[2][4];
#pragma unroll
        for (int r = 0; r < 2; ++r) { const int row = r ? rB : rA;
            f32x4 mv[4]; float ss = 0.f;
#pragma unroll
            for (int i = 0; i < 4; ++i) { const u32x2 w = mw[r][i];
                mv[i] = (f32x4){bflo(w.x), bfhi(w.x), bflo(w.y), bfhi(w.y)}; ss += mv[i][0] * mv[i][0] + mv[i][1] * mv[i][1] + mv[i][2] * mv[i][2] + mv[i][3] * mv[i][3]; }
            ss = wave_sum(ss); const float rr = __builtin_amdgcn_rsqf(ss * (1.0f / D_) + EPS_);
#pragma unroll
            for (int i = 0; i < 4; ++i) { const f32x4 gp = *(const f32x4*)(gpost + i * 256 + lane * 4); x[r][i] += mv[i] * rr * gp; }
            float sb = 0.f;
#pragma unroll
            for (int i = 0; i < 4; ++i) { const u32x2 w = mw2[r][i];
                mv[i] = (f32x4){bflo(w.x), bfhi(w.x), bflo(w.y), bfhi(w.y)}; sb += mv[i][0] * mv[i][0] + mv[i][1] * mv[i][1] + mv[i][2] * mv[i][2] + mv[i][3] * mv[i][3]; }
            sb = wave_sum(sb); const float rb = __builtin_amdgcn_rsqf(sb * (1.0f / D_) + EPS_);
            float s2 = 0.f;
#pragma unroll
            for (int i = 0; i < 4; ++i) { const f32x4 gp = *(const f32x4*)(gpost2 + i * 256 + lane * 4); x[r][i] += mv[i] * rb * gp; __builtin_nontemporal_store(x[r][i], (f32x4*)(xout + (size_t)row * D_ + i * 256 + lane * 4));
                s2 += x[r][i][0] * x[r][i][0] + x[r][i][1] * x[r][i][1] + x[r][i][2] * x[r][i][2] + x[r][i][3] * x[r][i][3]; }
            s2 = wave_sum(s2); const float r2 = __builtin_amdgcn_rsqf(s2 * (1.0f / D_) + EPS_);
#pragma unroll
            for (int i = 0; i < 4; ++i) { const f32x4 gn = *(const f32x4*)(gnext + i * 256 + lane * 4); hv[r][i] = x[r][i] * r2 * gn; }
        }
        const float sg = (sq & 1) ? -1.f : 1.f;
#pragma unroll
        for (int i = 0; i < 4; ++i) { const f32x4 he = sq ? hv[0][i] + hv[1][i] : hv[0][i]; const f32x4 ho = sq ? hv[0][i] - hv[1][i] : (f32x4){0.f, 0.f, 0.f, 0.f};
            al[i] += sq ? he * sg : hv[0][i] + hv[1][i];
            u32x2 w; w.x = cvt_pk_bf16(he[0], he[1]); w.y = cvt_pk_bf16(he[2], he[3]); *(u32x2*)(He + ((size_t)b * 2048 + sq) * D_ + i * 256 + lane * 4) = w;
            w.x = cvt_pk_bf16(ho[0], ho[1]); w.y = cvt_pk_bf16(ho[2], ho[3]); *(u32x2*)(Ho + ((size_t)b * 2048 + sq) * D_ + i * 256 + lane * 4) = w;
            if (sq == 0) *(f32x4*)(h2048 + b * 1024 + i * 256 + lane * 4) = hv[1][i]; }
#pragma unroll
        for (int r = 0; r < 2; ++r)
#pragma unroll
            for (int i = 0; i < 4; ++i) { x[r][i] = xn[r][i]; mw[r][i] = mn[r][i]; mw2[r][i] = mn2[r][i]; }
    }
    if (curb >= 0) {
#pragma unroll
        for (int i = 0; i < 4; ++i)
#pragma unroll
            for (int j = 0; j < 4; ++j) atomicAdd(alt + curb * 1024 + i * 256 + lane * 4 + j, al[i][j]); }
#undef FOLD_ROWS
#undef FOLD_LOAD
}

#define LANE_TID const int lane = lane_id_asm(); const int wid = wave_s; const int tid = wid * 64 + lane; (void)tid; (void)lane; (void)wid
enum { PH_PREP = 0, PH_G1, PH_CONV, PH_GATES, PH_ATTN, PH_SCAN2, PH_MIXOUT, PH_ROW1, PH_FFN1, PH_FFN2, PH_ROW2, PH_DFTC, PH_DFTS, PH_FOUT, PH_PRE, PH_DFTQ };
constexpr int N_PHASES = 1 + 10 + 7 + 10 + 7;

DI void decode_phase(int ph, int& type, int& layer) {
    if (ph == 0) { type = PH_PREP; layer = 0; return; }
    int p = ph - 1;
    if (p < 10) { layer = 0; type = PH_G1 + p; return; }
    p -= 10;
    if (p < 7) { layer = 1; type = p < 3 ? PH_DFTC + p : PH_ROW1 + (p - 3); return; }
    p -= 7;
    if (p < 10) { layer = 2; type = PH_G1 + p; return; }
    p -= 10;
    layer = 3; type = p < 3 ? PH_DFTC + p : PH_ROW1 + (p - 3);
}

__global__ void __launch_bounds__(512, 2) fwd_megakernel(Params Pk) {
    extern __shared__ __attribute__((aligned(16))) unsigned char shm[];
    LAS unsigned char* lds = (LAS unsigned char*)shm;
    cg::grid_group grid = cg::this_grid();
    const int ph_lo = Pk.ph_lo, ph_hi = Pk.ph_hi;
    const int wave_s = __builtin_amdgcn_readfirstlane((int)(threadIdx.x >> 6));
    if (threadIdx.x < 4) ((volatile LAS unsigned*)(lds + LDS_BARW))[threadIdx.x] = 0u;
    __syncthreads();
    if (threadIdx.x == 0) (void)xb_add(&((unsigned*)(Pk.ws + WS_MISC + MI_BAR))[XB_XCNT(xb_xcc_id())], 1u);
    for (int ph = ph_lo; ph < ph_hi; ++ph) {
        typedef const __attribute__((address_space(4))) Params* KP;
        KP pp = (KP)__builtin_amdgcn_kernarg_segment_ptr(); asm volatile("" : "+s"(pp));
        const __attribute__((address_space(4))) Params& P = *pp;
        unsigned char* ws = P.ws; asm volatile("" : "+s"(ws));
        bf16_t* WIN = (bf16_t*)(ws + WS_WIN); bf16_t* WOUT = (bf16_t*)(ws + WS_WOUT); bf16_t* WF = (bf16_t*)(ws + WS_WF);
        bf16_t* WGU = (bf16_t*)(ws + WS_WGU); bf16_t* WD = (bf16_t*)(ws + WS_WD); bf16_t* WLRU = (bf16_t*)(ws + WS_WLRU); bf16_t* WDFT = (bf16_t*)(ws + WS_WDFT);
        float* NLS = (float*)(ws + WS_MISC + MI_NLS); float* LAMV = (float*)(ws + WS_MISC + MI_LAM); unsigned* KMAX = (unsigned*)(ws + WS_MISC + MI_KMAX);
        f32x2* AGG = (f32x2*)(ws + WS_MISC + MI_AGG);
        bf16_t* HN = (bf16_t*)(ws + WS_A); bf16_t* CAT = HN;
        bf16_t* QB = (bf16_t*)(ws + WS_B); bf16_t* KB = QB + (size_t)T_ * 512; bf16_t* VT = KB + (size_t)T_ * 512; bf16_t* XR = VT + (size_t)T_ * 512;
        float* HF = (float*)(ws + WS_B); bf16_t* FB = (bf16_t*)(ws + WS_B);
        bf16_t* DM = (bf16_t*)(ws + WS_B + 64 * MiB); bf16_t* MB = DM;
        bf16_t* GY = (bf16_t*)(ws + WS_GY);
        bf16_t* CSM = (bf16_t*)(ws + WS_CS); float* Y2048 = (float*)(ws + WS_MISC + MI_Y2048); bf16_t* YE = (bf16_t*)(ws + WS_E + 64 * MiB); bf16_t* HE = (bf16_t*)(ws + WS_E); bf16_t* HO = (bf16_t*)(ws + WS_E + 32 * MiB); float* ALT0 = (float*)(ws + WS_MISC + MI_ALT); float* H2048 = (float*)(ws + WS_MISC + MI_H2048); float* PM = (float*)(ws + WS_B + 64 * MiB);
        unsigned* AU = (unsigned*)(ws + WS_E); bf16_t* XC = (bf16_t*)(ws + WS_E + 128 * MiB); bf16_t* ACT = (bf16_t*)(ws + WS_E); bf16_t* YT = (bf16_t*)(ws + WS_E);

        const int code_ = P.tab[ph]; const int type = code_ & 15, l = (code_ >> 4) & 3, pflag = code_ >> 6;
        const int e = l >> 1;
        float* ALT = ALT0 + e * 8192;
#ifdef ONLY_PHASE
        if (type != ONLY_PHASE) continue;
#endif
        switch (type) {
        case PH_PREP: { LANE_TID;
            LAS float* tl = (LAS float*)lds;
            for (int ee = 0; ee < 2; ++ee) {
                transpose_cvt(tid, tl, P.in[5] + (size_t)ee * D_ * INC_, D_, INC_, WIN + (size_t)ee * INC_ * D_, D_, 3);
                transpose_cvt(tid, tl, P.in[6] + (size_t)ee * D_ * D_, D_, D_, WOUT + (size_t)ee * D_ * D_, D_, 0);
                transpose_cvt(tid, tl, P.in[19] + (size_t)ee * D_ * D_, D_, D_, WF + (size_t)ee * D_ * D_, D_, 0);
            }
            for (int ll = 0; ll < 4; ++ll) {
                transpose_cvt(tid, tl, P.in[20] + (size_t)ll * D_ * FF_, D_, FF_, WGU + (size_t)ll * 2 * FF_ * D_, D_, 1);
                transpose_cvt(tid, tl, P.in[21] + (size_t)ll * D_ * FF_, D_, FF_, WGU + (size_t)ll * 2 * FF_ * D_, D_, 2);
                transpose_cvt(tid, tl, P.in[22] + (size_t)ll * FF_ * D_, FF_, D_, WD + (size_t)ll * D_ * FF_, FF_, 0);
            }
            const int gtid = blockIdx.x * 512 + tid, gn = gridDim.x * 512;
            for (int idx = gtid; idx < 2 * 4 * 512 * 256; idx += gn) {
                const int k = idx & 255, row = (idx >> 8) & 511, h = (idx >> 17) & 3, ee = idx >> 19;
                const int dir = row >> 8, gate = (row >> 7) & 1, j = row & 127;
                float v = 0.f;
                if (k < 128) v = (gate ? P.in[16] : P.in[14])[((size_t)((ee * 2 + dir) * 4 + h) * 128 + k) * 128 + j];
                WLRU[idx] = (bf16_t)(cvt_pk_bf16(v, 0.f) & 0xffffu);
            }
            for (int idx = gtid; idx < 512 * 256; idx += gn) {
                const int c = idx & 255, n = (idx >> 8) & 255, part = idx >> 16;
                const float ang = (float)((n * c) & 255) * (1.0f / 128.0f); float sv, cv; sincospif(ang, &sv, &cv);
                WDFT[idx] = (bf16_t)(cvt_pk_bf16((part ? sv : cv) * 0.0625f, 0.f) & 0xffffu);
            }
            for (int idx = gtid; idx < 2 * 2048 * 256; idx += gn) {
                const int s0 = (idx & 255) * 8, k = (idx >> 8) & 2047, part = idx >> 19; float v[8];
#pragma unroll
                for (int j = 0; j < 8; ++j) { const int p = (k * (s0 + j)) & 4095; float sv, cv; sincospif((float)p * (1.0f / 2048.0f), &sv, &cv); v[j] = (part ? sv : cv) * (1.0f / 64.0f); }
                u32x4 w; w.x = cvt_pk_bf16(v[0], v[1]); w.y = cvt_pk_bf16(v[2], v[3]); w.z = cvt_pk_bf16(v[4], v[5]); w.w = cvt_pk_bf16(v[6], v[7]);
                *(u32x4*)(CSM + (size_t)idx * 8) = w;
            }
            for (int idx = gtid; idx < 2 * 2 * 512; idx += gn) { const float x = P.in[18][idx]; NLS[idx] = -8.0f * __builtin_amdgcn_logf(1.0f + __builtin_amdgcn_exp2f(-x * LOG2E)); }
            if (blockIdx.x == 0 && tid < 128) KMAX[tid] = 0u;
            for (int idx = gtid; idx < 2 * 8192; idx += gn) ((float*)(ws + WS_MISC + MI_ALT))[idx] = 0.f;
            if (blockIdx.x == 0 && wid < 2) {
                const float a = wave_sum(P.in[7][wid * 64 + lane] * P.in[8][wid * 64 + lane]);
                const float b = wave_sum(P.in[9][wid * 64 + lane] * P.in[10][wid * 64 + lane]);
                int wq = wid; asm volatile("" : "+s"(wq)); const float li = wq == 0 ? 0.2f : 0.47071302f;
                if (lane == 0) LAMV[wid] = __builtin_amdgcn_exp2f(a * LOG2E) - __builtin_amdgcn_exp2f(b * LOG2E) + li;
            }
            rowpass(tid, P.in[0], nullptr, nullptr, nullptr, P.in[1], HN);
        } break;

        case PH_G1: { LANE_TID;
            pg8::Gemm g{HN, WIN + (size_t)e * INC_ * D_, D_, D_, D_, T_ / 256, INC_ / 256, 1, 0, 0};
            g.A2 = WIN + (size_t)e * INC_ * D_ + (size_t)2048 * D_; g.swapN = 8;
            pg8::EpiG1 E{QB, KB, VT, XR, GY};
            pg8::gemm_phase(lds, g, E, tid);
        } break;

        case PH_CONV: { LANE_TID;
            const float* cw = P.in[12] + (size_t)e * 4 * 512; const float* cb = P.in[13] + (size_t)e * 512;
            const int ch = lane * 8;
            float w[4][8], bb[8];
#pragma unroll
            for (int j = 0; j < 4; ++j)
#pragma unroll
                for (int i = 0; i < 8; ++i) w[j][i] = cw[j * 512 + ch + i];
#pragma unroll
            for (int i = 0; i < 8; ++i) bb[i] = cb[ch + i];
            for (int tb = blockIdx.x; tb < 256; tb += gridDim.x) {
                float kmx = 0.f;
                for (int it = 0; it < 4; ++it) {
                    const int t0 = tb * 128 + it * 32 + wid * 4, s0 = t0 & 4095;
                    u32x4 xr7[7], kv4[4];
#pragma unroll
                    for (int r = 0; r < 7; ++r) { const int ss = s0 + r - 2; xr7[r] = (u32x4){0u, 0u, 0u, 0u};
                        if (ss >= 0 && ss < S_) xr7[r] = *(const u32x4*)(XR + (size_t)(t0 + r - 2) * 512 + ch); }
#pragma unroll
                    for (int q = 0; q < 4; ++q) kv4[q] = *(const u32x4*)(KB + (size_t)(t0 + q) * 512 + ch);
#pragma unroll
                    for (int q = 0; q < 4; ++q) {
                        float accv[8];
#pragma unroll
                        for (int i = 0; i < 8; ++i) accv[i] = bb[i];
#pragma unroll
                        for (int j = 0; j < 4; ++j) { const u32x4 xv = xr7[q + j];
                            accv[0] += w[j][0] * bflo(xv.x); accv[1] += w[j][1] * bfhi(xv.x); accv[2] += w[j][2] * bflo(xv.y); accv[3] += w[j][3] * bfhi(xv.y);
                            accv[4] += w[j][4] * bflo(xv.z); accv[5] += w[j][5] * bfhi(xv.z); accv[6] += w[j][6] * bflo(xv.w); accv[7] += w[j][7] * bfhi(xv.w); }
                        u32x4 o; o.x = cvt_pk_bf16(accv[0], accv[1]); o.y = cvt_pk_bf16(accv[2], accv[3]); o.z = cvt_pk_bf16(accv[4], accv[5]); o.w = cvt_pk_bf16(accv[6], accv[7]);
                        *(u32x4*)(XC + (size_t)(t0 + q) * 512 + ch) = o;
                        const u32x4 kv = kv4[q];
                        float q2 = bflo(kv.x) * bflo(kv.x) + bfhi(kv.x) * bfhi(kv.x) + bflo(kv.y) * bflo(kv.y) + bfhi(kv.y) * bfhi(kv.y)
                                 + bflo(kv.z) * bflo(kv.z) + bfhi(kv.z) * bfhi(kv.z) + bflo(kv.w) * bflo(kv.w) + bfhi(kv.w) * bfhi(kv.w);
                        q2 += __shfl_xor(q2, 1); q2 += __shfl_xor(q2, 2); q2 += __shfl_xor(q2, 4);
                        kmx = fmaxf(kmx, q2);
                    }
                }
                if ((lane & 7) == 0) atomicMax(KMAX + e * 64 + (tb >> 5) * 8 + (lane >> 3), __float_as_uint(kmx));
            }
        } break;

        case PH_GATES: { LANE_TID;
            int kg_ = 128; asm volatile("" : "+s"(kg_));
            pg8::Gemm g{XC, WLRU + (size_t)e * 4 * 512 * 256, 512, 256, kg_, T_ / 256, 2, 4, 128, 512 * 256};
            pg8::EpiGates E{XC, P.in[15] + (size_t)e * 1024, P.in[17] + (size_t)e * 1024, NLS + e * 1024, AU};
            pg8::gemm_phase(lds, g, E, tid);
        } break;

        case PH_ATTN: { LANE_TID;
            for (int idx = blockIdx.x * 512 + tid; idx < 2 * 8 * 32 * 128; idx += gridDim.x * 512) {
                const int c4 = idx & 127, chunk = (idx >> 7) & 31, b = (idx >> 12) & 7, dir = idx >> 15;
                const unsigned* p = AU + ((size_t)dir * T_ + b * S_ + chunk * 128) * 512 + c4 * 4;
                float LA[4] = {0.f, 0.f, 0.f, 0.f}, H[4] = {0.f, 0.f, 0.f, 0.f};
                for (int s0 = 0; s0 < 128; s0 += 16) {
                    u32x4 w[16];
#pragma unroll
                    for (int i = 0; i < 16; ++i) { const int s = dir == 0 ? (s0 + i) : (127 - s0 - i); w[i] = *(const u32x4*)(p + (size_t)s * 512); }
#pragma unroll
                    for (int i = 0; i < 16; ++i)
#pragma unroll
                        for (int j = 0; j < 4; ++j) { const float la = bflo(w[i][j]); LA[j] += la; H[j] = __builtin_amdgcn_exp2f(la) * H[j] + bfhi(w[i][j]); }
                }
#pragma unroll
                for (int j = 0; j < 4; ++j) AGG[(((size_t)b * 32 + chunk) * 512 + c4 * 4 + j) * 2 + dir] = (f32x2){LA[j], H[j]};
            }
            const int fr = lane & 15, fq = lane >> 4;
            const float lamv = LAMV[e];
            const float lam_init = l == 0 ? 0.2f : 0.47071302f;
            constexpr int KBUF = 16384, VBUF = 16384, BUFB = KBUF + VBUF;
            unsigned* AQ = (unsigned*)(ws + WS_MISC + MI_BAR) + (e * 8 + (int)(blockIdx.x & 7));
            LAS int* qslot = (LAS int*)(lds + LDS_MBW + 32);
            __syncthreads();
            if (tid == 0) *qslot = (int)atomicAdd(AQ, 1u);
            __syncthreads();
            int n_cur = *qslot;
            while (n_cur < 128) {
                unsigned n_nxt = 0u; if (tid == 0) n_nxt = atomicAdd(AQ, 1u);
                const int h = 3 - (n_cur >> 5), qb = n_cur & 31, b = (int)(blockIdx.x & 7);
                const int tok0 = b * S_, q0 = qb * 128 + wid * 16;
                const float slope2 = __builtin_amdgcn_exp2f(-2.0f * (float)(h + 1)) * LOG2E;
                bf16x8 Qf[2][2];
                float mb = 0.f, gap = 0.f;
#pragma unroll
                for (int mm = 0; mm < 2; ++mm) { float q2 = 0.f, sii = 0.f;
#pragma unroll
                    for (int ks = 0; ks < 2; ++ks) { Qf[mm][ks] = *(const bf16x8*)(QB + (size_t)(tok0 + q0 + fr) * 512 + h * 128 + mm * 64 + ks * 32 + fq * 8);
                        const bf16x8 kd = *(const bf16x8*)(KB + (size_t)(tok0 + q0 + fr) * 512 + h * 128 + mm * 64 + ks * 32 + fq * 8);
#pragma unroll
                        for (int j = 0; j < 8; ++j) { const float v = bf2f((unsigned short)Qf[mm][ks][j]); q2 += v * v; sii += v * bf2f((unsigned short)kd[j]); } }
                    q2 += __shfl_xor(q2, 16); q2 += __shfl_xor(q2, 32); sii += __shfl_xor(sii, 16); sii += __shfl_xor(sii, 32);
                    const float k2 = __uint_as_float(KMAX[e * 64 + b * 8 + h * 2 + mm]);
                    const float bm = __builtin_sqrtf(q2 * k2);
                    mb = fmaxf(mb, bm); gap = fmaxf(gap, bm - sii); }
                const f32x4 cinit = (f32x4){-mb, -mb, -mb, -mb};
                const float qf = (float)(q0 + fr);
                f32x4 o[2][8]; float lsum[2] = {0.f, 0.f};
#pragma unroll
                for (int mm = 0; mm < 2; ++mm)
#pragma unroll
                    for (int blk = 0; blk < 8; ++blk) o[mm][blk] = (f32x4){0.f, 0.f, 0.f, 0.f};
                const char* kbase = (const char*)(KB + (size_t)tok0 * 512 + h * 128); const char* vbase = (const char*)(VT + (size_t)(b * 512 + h * 128) * S_);
                unsigned goff[4];
#pragma unroll
                for (int i = 0; i < 4; ++i) { const int sg = ((wid & 3) * 4 + i) * 64 + lane, p = sg >> 8, w = sg & 255;
                    if (wid < 4) { const int lam = w >> 2, cpos = (w & 3) ^ ((lam >> 2) & 3);
                        const int key = (lam & 32) + 8 * ((lam & 15) >> 2) + 4 * ((lam >> 4) & 1) + (lam & 3); goff[i] = (unsigned)(key * 1024 + (cpos * 4 + p) * 16); }
                    else { const int d = w >> 1, kgp = (w & 1) ^ ((d >> 3) & 1); goff[i] = (unsigned)(d * 8192 + (kgp * 4 + p) * 16); } }
                unsigned kro[4], vro[2];
#pragma unroll
                for (int cp = 0; cp < 4; ++cp) kro[cp] = (unsigned)(fq * 4096 + fr * 64 + ((cp ^ ((fr >> 2) & 3)) << 4));
#pragma unroll
                for (int kg = 0; kg < 2; ++kg) vro[kg] = (unsigned)(fq * 4096 + fr * 32 + ((kg ^ ((fr >> 3) & 1)) << 4));
#define ATT_DMA(tt, sl) do { const char* gb_ = (wid < 4) ? (kbase + (size_t)(tt) * 65536) : (vbase + (size_t)(tt) * 128); \
                    _Pragma("unroll") for (int i = 0; i < 4; ++i) \
                        __builtin_amdgcn_global_load_lds((const unsigned*)(gb_ + goff[i]), (LAS unsigned*)(lds + (sl) * BUFB + (wid * 4 + i) * 1024), 16, 0, 0); } while (0)
#define ATT_WAIT_TILE() do { if (wid == 7) asm volatile("s_waitcnt vmcnt(2)" ::: "memory"); else asm volatile("s_waitcnt vmcnt(6)" ::: "memory"); } while (0)
                __syncthreads();
                { float mw = gap; mw = fmaxf(mw, __shfl_xor(mw, 1)); mw = fmaxf(mw, __shfl_xor(mw, 2)); mw = fmaxf(mw, __shfl_xor(mw, 4)); mw = fmaxf(mw, __shfl_xor(mw, 8));
                  if (lane == 0) ((LAS float*)(lds + LDS_MBW))[wid] = mw; }
                __syncthreads();
                float mbmax = 0.f;
#pragma unroll
                for (int w8 = 0; w8 < 8; ++w8) mbmax = fmaxf(mbmax, ((const LAS float*)(lds + LDS_MBW))[w8]);
                const float d0f = fminf((fmaxf(mbmax, 0.f) + 50.0f) / slope2, 8192.0f);
                const int d0 = (int)d0f + 1;
                int t_lo = (qb * 128 - d0 + 1); t_lo = t_lo < 0 ? 0 : (t_lo >> 6);
                int t_hi = (qb * 128 + 127 + d0 - 1) >> 6; t_hi = t_hi > 63 ? 63 : t_hi;
                t_lo = __builtin_amdgcn_readfirstlane(t_lo); t_hi = __builtin_amdgcn_readfirstlane(t_hi);
#define ATT_SOFTMAX(tt, kg, P8x) do { _Pragma("unroll") for (int ti = 0; ti < 2; ++ti) { const float dq = qf - (float)((tt) * 64 + (kg) * 32 + ti * 4 + fq * 8); \
                        _Pragma("unroll") for (int j = 0; j < 4; ++j) { const float bias = slope2 * __builtin_fabsf(dq - (float)j); \
                            _Pragma("unroll") for (int mm = 0; mm < 2; ++mm) { const float p = __builtin_amdgcn_exp2f(st[kg][mm][ti][j] - bias); st[kg][mm][ti][j] = p; lsum[mm] += p; } } } \
                        _Pragma("unroll") for (int mm = 0; mm < 2; ++mm) { u32x4 w; w.x = cvt_pk_nv(st[kg][mm][0][0], st[kg][mm][0][1]); w.y = cvt_pk_nv(st[kg][mm][0][2], st[kg][mm][0][3]); \
                            w.z = cvt_pk_nv(st[kg][mm][1][0], st[kg][mm][1][1]); w.w = cvt_pk_nv(st[kg][mm][1][2], st[kg][mm][1][3]); P8x[mm] = __builtin_bit_cast(bf16x8, w); } } while (0)
#define ATT_H1(tt, sl) do { const LAS unsigned char* kl = lds + (sl) * BUFB; bf16x8 kf[2][2][2][2]; \
                    _Pragma("unroll") for (int kg = 0; kg < 2; ++kg) _Pragma("unroll") for (int ti = 0; ti < 2; ++ti) _Pragma("unroll") for (int mm = 0; mm < 2; ++mm) _Pragma("unroll") for (int ks = 0; ks < 2; ++ks) \
                        kf[kg][ti][mm][ks] = *(const LAS bf16x8*)(kl + kro[mm * 2 + ks] + (kg * 32 + ti * 16) * 64); \
                    __builtin_amdgcn_sched_barrier(0); \
                    f32x4 st[2][2][2]; __builtin_amdgcn_s_setprio(1); \
                    _Pragma("unroll") for (int kg = 0; kg < 2; ++kg) _Pragma("unroll") for (int ti = 0; ti < 2; ++ti) _Pragma("unroll") for (int mm = 0; mm < 2; ++mm) \
                        st[kg][mm][ti] = __builtin_amdgcn_mfma_f32_16x16x32_bf16(kf[kg][ti][mm][0], Qf[mm][0], cinit, 0, 0, 0); \
                    _Pragma("unroll") for (int kg = 0; kg < 2; ++kg) _Pragma("unroll") for (int ti = 0; ti < 2; ++ti) _Pragma("unroll") for (int mm = 0; mm < 2; ++mm) \
                        st[kg][mm][ti] = __builtin_amdgcn_mfma_f32_16x16x32_bf16(kf[kg][ti][mm][1], Qf[mm][1], st[kg][mm][ti], 0, 0, 0); \
                    __builtin_amdgcn_s_setprio(0); __builtin_amdgcn_sched_barrier(0); \
                    ATT_SOFTMAX(tt, 0, P8a); ATT_SOFTMAX(tt, 1, P8b); \
                    __builtin_amdgcn_sched_barrier(0); } while (0)
#define ATT_H2(sl) do { const LAS unsigned char* vl = lds + (sl) * BUFB + KBUF; bf16x8 vf0[8], vf1[8]; \
                    _Pragma("unroll") for (int blk = 0; blk < 8; ++blk) vf0[blk] = *(const LAS bf16x8*)(vl + vro[0] + blk * 512); \
                    _Pragma("unroll") for (int blk = 0; blk < 8; ++blk) vf1[blk] = *(const LAS bf16x8*)(vl + vro[1] + blk * 512); \
                    __builtin_amdgcn_sched_barrier(0); __builtin_amdgcn_s_setprio(1); \
                    _Pragma("unroll") for (int blk = 0; blk < 8; ++blk) { \
                        o[0][blk] = __builtin_amdgcn_mfma_f32_16x16x32_bf16(vf0[blk], P8a[0], o[0][blk], 0, 0, 0); \
                        o[1][blk] = __builtin_amdgcn_mfma_f32_16x16x32_bf16(vf0[blk], P8a[1], o[1][blk], 0, 0, 0); } \
                    _Pragma("unroll") for (int blk = 0; blk < 8; ++blk) { \
                        o[0][blk] = __builtin_amdgcn_mfma_f32_16x16x32_bf16(vf1[blk], P8b[0], o[0][blk], 0, 0, 0); \
                        o[1][blk] = __builtin_amdgcn_mfma_f32_16x16x32_bf16(vf1[blk], P8b[1], o[1][blk], 0, 0, 0); } \
                    __builtin_amdgcn_s_setprio(0); __builtin_amdgcn_sched_barrier(0); } while (0)
                const int ntl = t_hi - t_lo + 1;
                const bool lag = wid >= 4;
                bf16x8 P8a[2], P8b[2];
                P8a[0] = P8a[1] = P8b[0] = P8b[1] = (bf16x8){0, 0, 0, 0, 0, 0, 0, 0};
                ATT_DMA(t_lo, 0);
                int slot = 0, pslot = 2;
                for (int it = 0; it <= ntl; ++it) {
                    asm volatile("s_waitcnt vmcnt(0)" ::: "memory");
                    __builtin_amdgcn_s_barrier(); asm volatile("" ::: "memory");
                    const int nslot = slot == 2 ? 0 : slot + 1;
                    if (it + 1 < ntl) ATT_DMA(t_lo + it + 1, nslot);
                    if (lag && it > 0) ATT_H2(pslot);
                    if (it < ntl) ATT_H1(t_lo + it, slot);
                    if (!lag && it < ntl) ATT_H2(slot);
                    pslot = slot; slot = nslot;
                }
#undef ATT_SOFTMAX
#undef ATT_H1
#undef ATT_H2
                asm volatile("s_waitcnt vmcnt(0)" ::: "memory");
#undef ATT_DMA
#undef ATT_WAIT_TILE
                float l0 = lsum[0], l1 = lsum[1];
                l0 += __shfl_xor(l0, 16); l0 += __shfl_xor(l0, 32); l1 += __shfl_xor(l1, 16); l1 += __shfl_xor(l1, 32);
                const float i0 = 1.0f / l0, i1 = lamv / l1;
                float ss = 0.f;
#pragma unroll
                for (int blk = 0; blk < 8; ++blk)
#pragma unroll
                    for (int j = 0; j < 4; ++j) { const float v = o[0][blk][j] * i0 - o[1][blk][j] * i1; o[0][blk][j] = v; ss += v * v; }
                ss += __shfl_xor(ss, 16); ss += __shfl_xor(ss, 32);
                const float rn = __builtin_amdgcn_rsqf(ss * (1.0f / 128.0f) + EPS_) * (1.0f - lam_init);
                const float* sg = P.in[11] + e * 128;
                bf16_t* op = CAT + (size_t)(tok0 + q0 + fr) * D_ + h * 128 + fq * 4;
#pragma unroll
                for (int blk = 0; blk < 8; ++blk) { const f32x4 gv = *(const f32x4*)(sg + blk * 16 + fq * 4);
                    u32x2 w; w.x = cvt_pk_bf16(o[0][blk][0] * rn * gv[0], o[0][blk][1] * rn * gv[1]); w.y = cvt_pk_bf16(o[0][blk][2] * rn * gv[2], o[0][blk][3] * rn * gv[3]);
                    *(u32x2*)(op + blk * 16) = w; }
                __syncthreads();
                if (tid == 0) *qslot = (int)n_nxt;
                __syncthreads();
                n_cur = *qslot;
            }
        } break;

        case PH_SCAN2: { LANE_TID;
            for (int idx = blockIdx.x * 512 + tid; idx < 8 * 32 * 512; idx += gridDim.x * 512) {
                const int c = idx & 511, chunk = (idx >> 9) & 31, b = idx >> 14;
                const size_t tbase = (size_t)b * S_ + chunk * 128;
                float H = 0.f;
                for (int cc = 0; cc < chunk; ++cc) { const f32x2 ag = AGG[(((size_t)b * 32 + cc) * 512 + c) * 2 + 0]; H = __builtin_amdgcn_exp2f(ag.x) * H + ag.y; }
                float hfr[128];
                { const unsigned* p = AU + tbase * 512 + c;
#pragma unroll
                  for (int s0 = 0; s0 < 128; s0 += 32) {
                      unsigned w[32];
#pragma unroll
                      for (int i = 0; i < 32; ++i) w[i] = __builtin_nontemporal_load(p + (size_t)(s0 + i) * 512);
#pragma unroll
                      for (int i = 0; i < 32; ++i) { H = __builtin_amdgcn_exp2f(bflo(w[i])) * H + bfhi(w[i]); hfr[s0 + i] = H; }
                  } }
                H = 0.f;
                for (int cc = 31; cc > chunk; --cc) { const f32x2 ag = AGG[(((size_t)b * 32 + cc) * 512 + c) * 2 + 1]; H = __builtin_amdgcn_exp2f(ag.x) * H + ag.y; }
                { const unsigned* p = AU + ((size_t)T_ + tbase) * 512 + c; const bf16_t* gp = GY + tbase * 512 + c; bf16_t* op = CAT + tbase * D_ + 512 + c;
#pragma unroll
                  for (int s0 = 127; s0 >= 0; s0 -= 16) {
                      unsigned w[16]; unsigned short gv[16];
#pragma unroll
                      for (int i = 0; i < 16; ++i) { const size_t s = (size_t)(s0 - i); w[i] = __builtin_nontemporal_load(p + s * 512); gv[i] = __builtin_nontemporal_load(gp + s * 512); }
#pragma unroll
                      for (int i = 0; i < 16; ++i) { H = __builtin_amdgcn_exp2f(bflo(w[i])) * H + bfhi(w[i]);
                          const float rec = (hfr[s0 - i] + H) * bf2f(gv[i]); op[(size_t)(s0 - i) * D_] = (bf16_t)(cvt_pk_bf16(rec, 0.f) & 0xffffu); }
                  } }
            }
        } break;

        case PH_MIXOUT: { LANE_TID;
            pg8::Gemm g{CAT, WOUT + (size_t)e * D_ * D_, D_, D_, D_, T_ / 256, D_ / 256, 1, 0, 0};
            pg8::EpiPlain E{MB, D_, 0};
            pg8::gemm_phase(lds, g, E, tid);
        } break;
        case PH_FOUT: { LANE_TID;
            pg8::Gemm g{FB, WF + (size_t)e * D_ * D_, D_, D_, D_, T_ / 256, D_ / 256, 1, 0, 0};
            pg8::EpiPlain E{MB, D_, 0};
            pg8::gemm_phase(lds, g, E, tid);
        } break;
        case PH_FFN2: { LANE_TID;
            pg8::Gemm g{ACT, WD + (size_t)l * D_ * FF_, FF_, FF_, FF_, T_ / 256, D_ / 256, 1, 0, 0};
            pg8::EpiPlain E{FB, D_, 0};
            pg8::gemm_phase(lds, g, E, tid);
        } break;
        case PH_PRE: { LANE_TID;
            const int chn = (tid & 127) * 8, sl = tid >> 7;
            for (int wgi = blockIdx.x; wgi < 256; wgi += gridDim.x) {
                const int b = wgi >> 5, sbase = (wgi & 31) * 64;
                float al[8];
#pragma unroll
                for (int i = 0; i < 8; ++i) al[i] = 0.f;
                for (int it4 = 0; it4 < 4; ++it4) {
                    u32x4 av4[4], bv4[4];
#pragma unroll
                    for (int u4 = 0; u4 < 4; ++u4) { const int sq = sbase + (it4 * 4 + u4) * 4 + sl;
                        av4[u4] = __builtin_nontemporal_load((const u32x4*)(HN + ((size_t)b * S_ + sq) * D_ + chn));
                        bv4[u4] = (u32x4){0u, 0u, 0u, 0u};
                        if (sq) bv4[u4] = __builtin_nontemporal_load((const u32x4*)(HN + ((size_t)b * S_ + (S_ - sq)) * D_ + chn)); }
#pragma unroll
                    for (int u4 = 0; u4 < 4; ++u4) { const int sq = sbase + (it4 * 4 + u4) * 4 + sl; const u32x4 av = av4[u4], bv = bv4[u4];
                        const float a[8] = {bflo(av.x), bfhi(av.x), bflo(av.y), bfhi(av.y), bflo(av.z), bfhi(av.z), bflo(av.w), bfhi(av.w)};
                        const float m8[8] = {bflo(bv.x), bfhi(bv.x), bflo(bv.y), bfhi(bv.y), bflo(bv.z), bfhi(bv.z), bflo(bv.w), bfhi(bv.w)};
                        float he[8], ho[8]; const float sg = (sq & 1) ? -1.f : 1.f;
#pragma unroll
                        for (int i = 0; i < 8; ++i) { he[i] = a[i] + m8[i]; ho[i] = sq ? a[i] - m8[i] : 0.f; al[i] += sg * he[i]; }
                        u32x4 w; w.x = cvt_pk_bf16(he[0], he[1]); w.y = cvt_pk_bf16(he[2], he[3]); w.z = cvt_pk_bf16(he[4], he[5]); w.w = cvt_pk_bf16(he[6], he[7]);
                        *(u32x4*)(HE + ((size_t)b * 2048 + sq) * D_ + chn) = w;
                        w.x = cvt_pk_bf16(ho[0], ho[1]); w.y = cvt_pk_bf16(ho[2], ho[3]); w.z = cvt_pk_bf16(ho[4], ho[5]); w.w = cvt_pk_bf16(ho[6], ho[7]);
                        *(u32x4*)(HO + ((size_t)b * 2048 + sq) * D_ + chn) = w;
                        if (sq == 0) { const u32x4 cv = *(const u32x4*)(HN + ((size_t)b * S_ + 2048) * D_ + chn);
                            const float c8[8] = {bflo(cv.x), bfhi(cv.x), bflo(cv.y), bfhi(cv.y), bflo(cv.z), bfhi(cv.z), bflo(cv.w), bfhi(cv.w)};
#pragma unroll
                            for (int i = 0; i < 8; ++i) { al[i] += c8[i]; H2048[b * 1024 + chn + i] = c8[i]; } }
                    }
                }
#pragma unroll
                for (int i = 0; i < 8; ++i) atomicAdd(ALT + b * 1024 + chn + i, al[i]);
            }
        } break;
        case PH_DFTS: { LANE_TID;
            if (pflag) {
                pg8::Gemm g{CSM, YE, 2048, 4096, 2048, 8, 4, 16, 0, (long)1024 * 4096, 8, (long)2048 * 2048, 2048};
                pg8::EpiDftPQ E{PM, Y2048, FB};
                pg8::gemm_phase(lds, g, E, tid);
            } else {
                pg8::Gemm g{CSM, YE, 2048, 4096, 2048, 8, 4, 8, 0, (long)1024 * 4096};
                pg8::EpiF32 E{PM, D_, 2048};
                pg8::gemm_phase(lds, g, E, tid);
            }
        } break;
        case PH_DFTQ: { LANE_TID;
            pg8::Gemm g{CSM + (size_t)2048 * 2048, YE + 2048, 2048, 4096, 2048, 8, 4, 8, 0, (long)1024 * 4096};
            pg8::EpiDftQ E{PM, Y2048, FB};
            pg8::gemm_phase(lds, g, E, tid);
        } break;

        case PH_ROW1: { LANE_TID;
            rowpass(tid, l == 0 ? P.in[0] : P.out, nullptr, MB, P.in[2] + l * D_, P.in[3] + l * D_, HN);
        } break;
        case PH_ROW2: { LANE_TID;
            if (pflag) rowpass_fold(tid, l == 0 ? P.in[0] : P.out, P.out, MB, P.in[2] + l * D_, FB, P.in[4] + l * D_, P.in[1] + (l + 1) * D_, HE, HO, ALT0 + (l >> 1) * 8192, H2048);
            else rowpass(tid, P.out, P.out, MB, P.in[2] + l * D_, l < 3 ? P.in[1] + (l + 1) * D_ : nullptr, l < 3 ? HN : nullptr, FB, P.in[4] + l * D_);
        } break;

        case PH_FFN1: { LANE_TID;
            pg8::Gemm g{HN, WGU + (size_t)l * 2 * FF_ * D_, D_, D_, D_, T_ / 256, 2 * FF_ / 256, 1, 0, 0};
            pg8::EpiSwiglu E{ACT};
            pg8::gemm_phase(lds, g, E, tid);
        } break;

        case PH_DFTC: { LANE_TID;
            for (int task = blockIdx.x * 8 + wid; task < 8 * 1024; task += gridDim.x * 8) {
                const int b = task >> 10, col = task & 1023, gq = col >> 8, n = col & 255;
                const u32x2 wv = *(const u32x2*)(WDFT + (size_t)n * 256 + lane * 4);
                const f32x4 hv = *(const f32x4*)(H2048 + b * 1024 + gq * 256 + lane * 4), av = *(const f32x4*)(ALT + b * 1024 + gq * 256 + lane * 4);
                const float w0 = bflo(wv.x), w1 = bfhi(wv.x), w2 = bflo(wv.y), w3 = bfhi(wv.y);
                const float d1 = wave_sum(w0 * hv[0] + w1 * hv[1] + w2 * hv[2] + w3 * hv[3]);
                const float d2 = wave_sum(w0 * av[0] + w1 * av[1] + w2 * av[2] + w3 * av[3]);
                if (lane == 0) { Y2048[task] = d1; FB[((size_t)b * S_ + 2048) * D_ + col] = (bf16_t)(cvt_pk_bf16(d2 * (1.0f / 64.0f), 0.f) & 0xffffu); }
            }
            pg8::Gemm g{WDFT, HE, 256, D_, 256, 1, 8 * 2048 / 256, 8, 0, 256, 4, 256 * 256, (long)(32 * MiB / 2)};
            pg8::EpiDftC2 E{YE};
            pg8::gemm_phase(lds, g, E, tid);
        } break;
        default: break;
        }
        if (ph + 1 < ph_hi) {
            if (ph_hi < 0) grid.sync();
            else { const int ln_ = lane_id_asm();
                   xcd_barrier((unsigned*)(ws + WS_MISC + MI_BAR), (volatile LAS unsigned*)(lds + LDS_BARW), wave_s == 0 && ln_ == 0); }
        }
    }
}

extern "C" void kernel_launch(void* const* d_in, const int* in_sizes, int n_in, void* d_out, int out_size, void* d_ws, size_t ws_size, hipStream_t stream) {
    constexpr size_t kDynLds = LDS_TOTAL;
    static int grid_blocks = 0;
    if (!grid_blocks) {
        int dev = 0, cus = 0, per_cu = 0;
        hipGetDevice(&dev);
        hipDeviceGetAttribute(&cus, hipDeviceAttributeMultiprocessorCount, dev);
        hipFuncSetAttribute((const void*)fwd_megakernel, hipFuncAttributeMaxDynamicSharedMemorySize, (int)kDynLds);
        hipOccupancyMaxActiveBlocksPerMultiprocessor(&per_cu, fwd_megakernel, 512, kDynLds);
        if (per_cu < 1) per_cu = 1;
        grid_blocks = cus * per_cu;
        if (ws_size < WS_END) fprintf(stderr, "kernel_launch: workspace too small: %zu < %zu\n", ws_size, (size_t)WS_END);
    }
    (void)hipMemsetAsync((unsigned char*)d_ws + WS_MISC + MI_BAR, 0, BAR_BYTES, stream);
    Params p{};
    for (int i = 0; i < 23; ++i) p.in[i] = (const float*)d_in[i];
    p.out = (float*)d_out; p.ws = (unsigned char*)d_ws;
    int nph = 0;
    {
        auto add = [&](int type, int l) { p.tab[nph++] = (unsigned char)(type | (l << 4)); if ((PROBE_DUP >> type) & 1) p.tab[nph++] = (unsigned char)(type | (l << 4)); };
        add(PH_PREP, 0);
        for (int l = 0; l < 4; ++l) {
            if ((l & 1) == 0) { add(PH_G1, l); add(PH_CONV, l); add(PH_GATES, l); add(PH_ATTN, l); add(PH_SCAN2, l); add(PH_MIXOUT, l); }
            else { add(PH_DFTC, l); if (grid_blocks == 256) { add(PH_DFTS, l); p.tab[nph - 1] |= 64; } else { add(PH_DFTS, l); add(PH_DFTQ, l); } add(PH_FOUT, l); }
            add(PH_ROW1, l); add(PH_FFN1, l); add(PH_FFN2, l); add(PH_ROW2, l); if ((l & 1) == 0) p.tab[nph - 1] |= 64;
        }
    }
#if MULTI_LAUNCH
    for (int ph = 0; ph < nph; ++ph) {
        p.ph_lo = ph; p.ph_hi = ph + 1;
        void* args[] = {&p};
        hipError_t e = hipLaunchCooperativeKernel((void*)fwd_megakernel, dim3(grid_blocks), dim3(512), args, kDynLds, stream);
        if (e != hipSuccess) { fprintf(stderr, "cooperative launch failed: %s (grid %d)\n", hipGetErrorString(e), grid_blocks); break; }
    }
#else
    p.ph_lo = 0; p.ph_hi = nph;
    void* args[] = {&p};
    hipError_t e = hipLaunchCooperativeKernel((void*)fwd_megakernel, dim3(grid_blocks), dim3(512), args, kDynLds, stream);
    if (e != hipSuccess) fprintf(stderr, "cooperative launch failed: %s (grid %d)\n", hipGetErrorString(e), grid_blocks);
#endif
}
```
